# Optimizing an MI355X kernel written in HIP

```python
import jax, jax.numpy as jnp
from jax import lax
import numpy as np

D_MODEL = 2048
BATCH = 2
SEQ = 8192
DEPTH = 4

N_MIXERS = 3
HEAD_DIM = 64
N_HEADS = D_MODEL // HEAD_DIM
N_KV_HEADS = N_HEADS // 8
GROUP = N_HEADS // N_KV_HEADS
ATTN_WIDTH = N_HEADS * HEAD_DIM
KV_WIDTH = N_KV_HEADS * HEAD_DIM
QKV_WIDTH = ATTN_WIDTH + 2 * KV_WIDTH
ROPE_DIM = HEAD_DIM // 4
ROPE_THETA = 500000.0
SCALE = HEAD_DIM ** -0.5
BLOCK = 128
SWA_WINDOW = 128
IDX_HEADS = 16
IDX_DIM = 64
IDX_SCALE = IDX_DIM ** -0.5
IDX_W_SCALE = IDX_HEADS ** -0.5
TOPK_MAX = 256
DSA_IN_WIDTH = QKV_WIDTH + IDX_HEADS * IDX_DIM + IDX_DIM + IDX_HEADS
DILATED_BRANCHES = ((128, 1), (512, 4), (2048, 16))
MAX_DIL_WINDOW = 2048
D_FF = 4 * D_MODEL
NORM_EPS = 1e-5
NEG_INF = -1e30
N_LAYERS_A = (DEPTH + 2) // 3
N_LAYERS_B = (DEPTH + 1) // 3
N_LAYERS_C = DEPTH // 3

kernel_name = "hybrid_swa_dsa_dilated_trunk"


def rms_norm(x, g):
    xf = x.astype(jnp.float32)
    y = xf * lax.rsqrt(jnp.mean(xf * xf, axis=-1, keepdims=True) + NORM_EPS)
    return (y * g.astype(jnp.float32)).astype(x.dtype)


def rope_tables(positions):
    inv = ROPE_THETA ** (-jnp.arange(0, ROPE_DIM, 2, dtype=jnp.float32) / ROPE_DIM)
    ang = positions.astype(jnp.float32)[..., None] * inv
    return jnp.cos(ang)[:, :, None, :], jnp.sin(ang)[:, :, None, :]


def apply_rope(x, cos, sin):
    half = ROPE_DIM // 2
    x1 = x[..., :half].astype(jnp.float32)
    x2 = x[..., half:ROPE_DIM].astype(jnp.float32)
    rot = jnp.concatenate([x1 * cos - x2 * sin, x2 * cos + x1 * sin], axis=-1).astype(x.dtype)
    return jnp.concatenate([rot, x[..., ROPE_DIM:]], axis=-1)


def split_qkv(proj, cos, sin):
    B, T = proj.shape[:2]
    q = proj[..., :ATTN_WIDTH].reshape(B, T, N_HEADS, HEAD_DIM)
    k = proj[..., ATTN_WIDTH:ATTN_WIDTH + KV_WIDTH].reshape(B, T, N_KV_HEADS, HEAD_DIM)
    v = proj[..., ATTN_WIDTH + KV_WIDTH:QKV_WIDTH].reshape(B, T, N_KV_HEADS, HEAD_DIM)
    q = apply_rope(q, cos, sin).reshape(B, T, N_KV_HEADS, GROUP, HEAD_DIM)
    k = apply_rope(k, cos, sin)
    return q, k, v


def block_map(fn, batch, seq):
    starts = jnp.arange(seq // BLOCK, dtype=jnp.int32) * BLOCK
    out = lax.map(fn, starts)
    return jnp.swapaxes(out, 0, 1).reshape(batch, seq, out.shape[-1])


def sliding_window_attention(h, w_in, sinks, w_out, cos, sin):
    B, T, _ = h.shape
    q, k, v = split_qkv(h @ w_in, cos, sin)
    pad = ((0, 0), (SWA_WINDOW, 0), (0, 0), (0, 0))
    k_pad, v_pad = jnp.pad(k, pad), jnp.pad(v, pad)
    sink = sinks.astype(jnp.float32).reshape(N_KV_HEADS, GROUP, 1, 1)
    span = BLOCK + SWA_WINDOW

    def one_block(t0):
        qb = lax.dynamic_slice_in_dim(q, t0, BLOCK, axis=1)
        kb = lax.dynamic_slice_in_dim(k_pad, t0, span, axis=1)
        vb = lax.dynamic_slice_in_dim(v_pad, t0, span, axis=1)
        qpos = t0 + jnp.arange(BLOCK)
        kpos = t0 - SWA_WINDOW + jnp.arange(span)
        dist = qpos[:, None] - kpos[None, :]
        mask = (dist >= 0) & (dist < SWA_WINDOW) & (kpos[None, :] >= 0)
        s = jnp.einsum('bqkgd,bskd->bkgqs', qb, kb).astype(jnp.float32) * SCALE
        s = jnp.where(mask, s, NEG_INF)
        m = jnp.maximum(jnp.max(s, axis=-1, keepdims=True), sink)
        p = jnp.exp(s - m)
        den = jnp.sum(p, axis=-1, keepdims=True) + jnp.exp(sink - m)
        o = jnp.einsum('bkgqs,bskd->bqkgd', (p / den).astype(v.dtype), vb)
        return o.reshape(B, BLOCK, ATTN_WIDTH)

    return block_map(one_block, B, T) @ w_out


def dsa_attention(h, w_in, w_out, cos, sin):
    B, T, _ = h.shape
    proj = h @ w_in
    q, k, v = split_qkv(proj[..., :QKV_WIDTH], cos, sin)
    o = QKV_WIDTH
    qi = proj[..., o:o + IDX_HEADS * IDX_DIM].reshape(B, T, IDX_HEADS, IDX_DIM)
    o += IDX_HEADS * IDX_DIM
    ki = proj[..., o:o + IDX_DIM][:, :, None, :]
    o += IDX_DIM
    wi = proj[..., o:o + IDX_HEADS]
    qi = apply_rope(qi, cos, sin)
    ki = apply_rope(ki, cos, sin)[:, :, 0]
    topk = min(TOPK_MAX, T // 4)
    kpos = jnp.arange(T)

    def one_block(t0):
        qib = lax.dynamic_slice_in_dim(qi, t0, BLOCK, axis=1)
        wib = lax.dynamic_slice_in_dim(wi, t0, BLOCK, axis=1).astype(jnp.float32) * IDX_W_SCALE
        qb = lax.dynamic_slice_in_dim(q, t0, BLOCK, axis=1)
        qpos = t0 + jnp.arange(BLOCK)
        rel = jax.nn.relu(jnp.einsum('bqhd,bsd->bqhs', qib, ki).astype(jnp.float32) * IDX_SCALE)
        score = jnp.einsum('bqhs,bqh->bqs', rel, wib)
        score = jnp.where(kpos[None, None, :] <= qpos[None, :, None], score, NEG_INF)
        _, idx = lax.top_k(score, topk)
        valid = idx <= qpos[None, :, None]
        k_sel = jax.vmap(lambda kb, ib: kb[ib])(k, idx)
        v_sel = jax.vmap(lambda vb, ib: vb[ib])(v, idx)
        s = jnp.einsum('bqkgd,bqskd->bkgqs', qb, k_sel).astype(jnp.float32) * SCALE
        s = jnp.where(valid[:, None, None], s, NEG_INF)
        p = jax.nn.softmax(s, axis=-1)
        out = jnp.einsum('bkgqs,bqskd->bqkgd', p.astype(v.dtype), v_sel)
        return out.reshape(B, BLOCK, ATTN_WIDTH)

    return block_map(one_block, B, T) @ w_out


def dilated_attention(h, w_in, w_out, cos, sin):
    B, T, _ = h.shape
    q, k, v = split_qkv(h @ w_in, cos, sin)
    pad = ((0, 0), (MAX_DIL_WINDOW, 0), (0, 0), (0, 0))
    k_pad, v_pad = jnp.pad(k, pad), jnp.pad(v, pad)

    def one_block(t0):
        qb = lax.dynamic_slice_in_dim(q, t0, BLOCK, axis=1)
        qpos = t0 + jnp.arange(BLOCK)
        maxes, dens, nums = [], [], []
        for window, dil in DILATED_BRANCHES:
            steps = jnp.arange(window // dil + 1)
            kpos = qpos[:, None] - dil * steps[None, :]
            kb = k_pad[:, kpos + MAX_DIL_WINDOW]
            vb = v_pad[:, kpos + MAX_DIL_WINDOW]
            s = jnp.einsum('bqkgd,bqjkd->bkgqj', qb, kb).astype(jnp.float32) * SCALE
            s = jnp.where(kpos >= 0, s, NEG_INF)
            m = jnp.max(s, axis=-1, keepdims=True)
            e = jnp.exp(s - m)
            maxes.append(m)
            dens.append(jnp.sum(e, axis=-1, keepdims=True))
            nums.append(jnp.einsum('bkgqj,bqjkd->bkgqd', e, vb.astype(jnp.float32)))
        mx = jnp.max(jnp.stack(maxes), axis=0)
        c0, c1, c2 = (jnp.exp(m - mx) for m in maxes)
        num = c0 * nums[0] + c1 * nums[1] + c2 * nums[2]
        den = c0 * dens[0] + c1 * dens[1] + c2 * dens[2]
        o = (num / den).astype(v.dtype)
        return jnp.transpose(o, (0, 3, 1, 2, 4)).reshape(B, BLOCK, ATTN_WIDTH)

    return block_map(one_block, B, T) @ w_out


def sq_relu_mlp(h, w_up, w_down):
    return jnp.square(jax.nn.relu(h @ w_up)) @ w_down


def setup_inputs(seed: int = 0) -> dict:
    key = jax.random.key(seed)
    ks = jax.random.split(key, 13)
    nrm = jax.random.normal
    x = nrm(ks[0], (BATCH, SEQ, D_MODEL), jnp.float32)
    positions = jnp.broadcast_to(jnp.arange(SEQ, dtype=jnp.int32), (BATCH, SEQ))
    norm_attn = 1.0 + 0.02 * nrm(ks[1], (DEPTH, D_MODEL), jnp.float32)
    norm_mlp = 1.0 + 0.02 * nrm(ks[2], (DEPTH, D_MODEL), jnp.float32)
    w_up = nrm(ks[3], (DEPTH, D_MODEL, D_FF), jnp.float32) * D_MODEL ** -0.5
    w_down = nrm(ks[4], (DEPTH, D_FF, D_MODEL), jnp.float32) * D_FF ** -0.5
    final_norm = 1.0 + 0.02 * nrm(ks[5], (D_MODEL,), jnp.float32)
    a_w_in = nrm(ks[6], (N_LAYERS_A, D_MODEL, QKV_WIDTH), jnp.float32) * D_MODEL ** -0.5
    a_sinks = 0.5 * nrm(ks[7], (N_LAYERS_A, N_HEADS), jnp.float32)
    a_w_out = nrm(ks[8], (N_LAYERS_A, ATTN_WIDTH, D_MODEL), jnp.float32) * ATTN_WIDTH ** -0.5
    b_w_in = nrm(ks[9], (N_LAYERS_B, D_MODEL, DSA_IN_WIDTH), jnp.float32) * D_MODEL ** -0.5
    b_w_out = nrm(ks[10], (N_LAYERS_B, ATTN_WIDTH, D_MODEL), jnp.float32) * ATTN_WIDTH ** -0.5
    c_w_in = nrm(ks[11], (N_LAYERS_C, D_MODEL, QKV_WIDTH), jnp.float32) * D_MODEL ** -0.5
    c_w_out = nrm(ks[12], (N_LAYERS_C, ATTN_WIDTH, D_MODEL), jnp.float32) * ATTN_WIDTH ** -0.5
    return {"x": x, "positions": positions, "norm_attn": norm_attn, "norm_mlp": norm_mlp,
            "w_up": w_up, "w_down": w_down, "final_norm": final_norm,
            "a_w_in": a_w_in, "a_sinks": a_sinks, "a_w_out": a_w_out,
            "b_w_in": b_w_in, "b_w_out": b_w_out, "c_w_in": c_w_in, "c_w_out": c_w_out}


def reference(x, positions, norm_attn, norm_mlp, w_up, w_down, final_norm,
              a_w_in, a_sinks, a_w_out, b_w_in, b_w_out, c_w_in, c_w_out):
    cos, sin = rope_tables(positions)
    for i in range(DEPTH):
        j = i // N_MIXERS
        kind = i % N_MIXERS
        h = rms_norm(x, norm_attn[i])
        if kind == 0:
            mix = sliding_window_attention(h, a_w_in[j], a_sinks[j], a_w_out[j], cos, sin)
        elif kind == 1:
            mix = dsa_attention(h, b_w_in[j], b_w_out[j], cos, sin)
        else:
            mix = dilated_attention(h, c_w_in[j], c_w_out[j], cos, sin)
        x = x + mix
        h = rms_norm(x, norm_mlp[i])
        x = x + sq_relu_mlp(h, w_up[i], w_down[i])
    return rms_norm(x, final_norm)
```

```cpp
#include <hip/hip_runtime.h>
#include <hip/hip_cooperative_groups.h>
#include <cstdio>
#include <cstdint>
namespace cg = cooperative_groups;

namespace pg8 {
#define PG8_LAS __attribute__((address_space(3)))
typedef unsigned short bf16_t;
typedef short bf16x8 __attribute__((ext_vector_type(8)));
typedef float f32x4 __attribute__((ext_vector_type(4)));
typedef unsigned u32x4 __attribute__((ext_vector_type(4)));
constexpr int BM = 256, BK = 64, HALF = 128, HTB = HALF * BK * 2  , STAGE_BYTES = 8 * HTB, NXCD = 8, WGM = 4;

__host__ __device__ __forceinline__ int lds_byte(int r, int c) { const int st = (r >> 4) * 2 + (c >> 5), rr = r & 15, cc = c & 31, ob = rr * 64 + cc * 2; return st * 1024 + (ob ^ (((ob >> 9) & 1) << 5)); }
__host__ __device__ __forceinline__ void stage_rc(int b, int& R, int& C) { const int st = b / 1024, sb = b % 1024, swz = sb ^ (((sb >> 9) & 1) << 5); R = (st >> 1) * 16 + swz / 64; C = (st & 1) * 32 + (swz % 64) / 2; }
__host__ __device__ __forceinline__ int perm32(int rho) { const int n = rho >> 4, i = rho & 15; return 8 * (i >> 2) + 4 * n + (i & 3); }

struct Unit { int pm, pn; };
struct Gemm { const bf16_t* A; const bf16_t* Bt; int M, N, K; };

struct StaticOrder {
    int nM, nN, nwg, G, c;
    __host__ __device__ void init(int M, int N, int G_, int c_) { nM = M / BM; nN = N / BM; nwg = nM * nN; G = G_; c = c_; }
    __host__ __device__ bool next(int i, Unit& u) const {
        const long L = (long)i * G + c; if (L >= nwg) return false;
        int wgid = (int)L; { const int q = nwg / NXCD, r = nwg % NXCD, xcd = wgid % NXCD, off = wgid / NXCD; wgid = (xcd < r ? xcd * (q + 1) : r * (q + 1) + (xcd - r) * q) + off; }
        const int nig = WGM * nN, gid = wgid / nig, fm = gid * WGM, gsz = (nM - fm) < WGM ? (nM - fm) : WGM;
        u.pm = fm + ((wgid % nig) % gsz); u.pn = (wgid % nig) / gsz; return true;
    }
    __device__ __forceinline__ void a_ready(const Unit&) const {}
    __device__ __forceinline__ void done(const Unit&) const {}
};

__device__ __forceinline__ unsigned cvt_pk_bf16(float lo, float hi) { unsigned r; asm volatile("v_cvt_pk_bf16_f32 %0, %1, %2" : "=v"(r) : "v"(lo), "v"(hi)); return r; }

constexpr int XD = 2048;
constexpr int LDQ = 3840;
constexpr float RMS_EPS = 1e-5f;
constexpr float SS_SCALE = 1048576.0f, SS_INV = 1.0f / 1048576.0f;

struct EpiQKV {
    static constexpr bool PERM = true, AFTER_DRAIN = false;
    bf16_t* O; const unsigned long long* ss; const float* rope; float* wi32;
    __device__ __forceinline__ static float x16(float v, bool odd) {
        const unsigned uu = __float_as_uint(v); auto rr = __builtin_amdgcn_permlane16_swap(uu, uu, false, false); return __uint_as_float(odd ? rr[0] : rr[1]); }
    __device__ __forceinline__ void operator()(const f32x4 (&acc)[2][2][4][2], const Unit& u, int wr, int wc, int fr, int fq) const {
        const int row0 = u.pm * BM + wr * 64 + fr; const int cb0 = u.pn * BM + wc * 32;
        unsigned long long sv[8];
#pragma unroll
        for (int i = 0; i < 8; ++i) sv[i] = ss[row0 + (i >> 2) * HALF + (i & 3) * 16];
        const bool rp0 = ((cb0 < 2304) || (cb0 >= 2560 && cb0 < 3648)) && ((cb0 & 32) == 0);
        const bool rp1 = ((cb0 + HALF < 2304) || (cb0 + HALF >= 2560 && cb0 + HALF < 3648)) && ((cb0 & 32) == 0);
        const bool anyrp = rp0 || rp1;
        f32x4 nr[4] = {};
        if (anyrp) { const float* rq = rope + (size_t)row0 * 16; nr[0] = *(const f32x4*)rq; nr[1] = *(const f32x4*)(rq + 4); nr[2] = *(const f32x4*)(rq + 8); nr[3] = *(const f32x4*)(rq + 12); }
#pragma unroll
        for (int it = 0; it < 8; ++it) {
            const int ai = it >> 2, m = it & 3;
            const int row = row0 + ai * HALF + m * 16;
            const float rs = 1.0f / sqrtf((float)sv[it] * (SS_INV / XD) + RMS_EPS);
            const f32x4 c0 = nr[0], c1 = nr[1], s0 = nr[2], s1 = nr[3];
            if (anyrp && it < 7) { const float* rq = rope + (size_t)(row0 + ((it + 1) >> 2) * HALF + ((it + 1) & 3) * 16) * 16;
                nr[0] = *(const f32x4*)rq; nr[1] = *(const f32x4*)(rq + 4); nr[2] = *(const f32x4*)(rq + 8); nr[3] = *(const f32x4*)(rq + 12); }
#pragma unroll
            for (int bj = 0; bj < 2; ++bj) {
                const int cb = cb0 + bj * HALF;
                f32x4 v0 = acc[ai][bj][m][0] * rs, v1 = acc[ai][bj][m][1] * rs;
                if (bj ? rp1 : rp0) {
                    f32x4 p0, p1;
#pragma unroll
                    for (int e = 0; e < 4; ++e) { p0[e] = x16(v0[e], fq & 1); p1[e] = x16(v1[e], fq & 1); }
                    if (fq == 0) { v0 = v0 * c0 - p0 * s0; v1 = v1 * c1 - p1 * s1; }
                    else if (fq == 1) { v0 = v0 * c0 + p0 * s0; v1 = v1 * c1 + p1 * s1; }
                }
                u32x4 w; w.x = cvt_pk_bf16(v0[0], v0[1]); w.y = cvt_pk_bf16(v0[2], v0[3]); w.z = cvt_pk_bf16(v1[0], v1[1]); w.w = cvt_pk_bf16(v1[2], v1[3]);
                *(u32x4*)(O + (size_t)row * LDQ + cb + 8 * fq) = w;
                if (cb == 3648 && fq < 2) { float* wp = wi32 + (size_t)row * 16 + 8 * fq; *(f32x4*)wp = v0; *(f32x4*)(wp + 4) = v1; }
            }
            asm volatile("" ::: "memory");
        }
    }
};
struct EpiRes {
    static constexpr bool PERM = true, AFTER_DRAIN = false;
    const float* base; float* out; bf16_t* xb; unsigned long long* ssn;
    __device__ __forceinline__ void operator()(const f32x4 (&acc)[2][2][4][2], const Unit& u, int wr, int wc, int fr, int fq) const {
        const int row0 = u.pm * BM + wr * 64 + fr; const int col0 = u.pn * BM + wc * 32 + 8 * fq;
        f32x4 nb[4];
        { const size_t off = (size_t)row0 * XD + col0; nb[0] = __builtin_nontemporal_load((const f32x4*)(base + off)); nb[1] = __builtin_nontemporal_load((const f32x4*)(base + off + 4)); nb[2] = __builtin_nontemporal_load((const f32x4*)(base + off + HALF)); nb[3] = __builtin_nontemporal_load((const f32x4*)(base + off + HALF + 4)); }
#pragma unroll
        for (int it = 0; it < 8; ++it) {
            const int ai = it >> 2, m = it & 3;
            const int row = row0 + ai * HALF + m * 16; float sq = 0.f;
            const f32x4 cb0 = nb[0], cb1 = nb[1], cb2 = nb[2], cb3 = nb[3];
            if (it < 7) { const size_t offn = (size_t)(row0 + ((it + 1) >> 2) * HALF + ((it + 1) & 3) * 16) * XD + col0;
                nb[0] = __builtin_nontemporal_load((const f32x4*)(base + offn)); nb[1] = __builtin_nontemporal_load((const f32x4*)(base + offn + 4)); nb[2] = __builtin_nontemporal_load((const f32x4*)(base + offn + HALF)); nb[3] = __builtin_nontemporal_load((const f32x4*)(base + offn + HALF + 4)); }
#pragma unroll
            for (int bj = 0; bj < 2; ++bj) {
                const size_t off = (size_t)row * XD + col0 + bj * HALF;
                const f32x4 v0 = acc[ai][bj][m][0] + (bj ? cb2 : cb0), v1 = acc[ai][bj][m][1] + (bj ? cb3 : cb1);
                if (out) { __builtin_nontemporal_store(v0, (f32x4*)(out + off)); __builtin_nontemporal_store(v1, (f32x4*)(out + off + 4)); }
                u32x4 w; w.x = cvt_pk_bf16(v0[0], v0[1]); w.y = cvt_pk_bf16(v0[2], v0[3]); w.z = cvt_pk_bf16(v1[0], v1[1]); w.w = cvt_pk_bf16(v1[2], v1[3]);
                if (xb) *(u32x4*)(xb + off) = w;
                sq += (v0[0] * v0[0] + v0[1] * v0[1]) + (v0[2] * v0[2] + v0[3] * v0[3]) + (v1[0] * v1[0] + v1[1] * v1[1]) + (v1[2] * v1[2] + v1[3] * v1[3]);
            }
            { const unsigned u1 = __float_as_uint(sq); auto r1 = __builtin_amdgcn_permlane16_swap(u1, u1, false, false); sq = __uint_as_float(r1[0]) + __uint_as_float(r1[1]);
              const unsigned u2 = __float_as_uint(sq); auto r2 = __builtin_amdgcn_permlane32_swap(u2, u2, false, false); sq = __uint_as_float(r2[0]) + __uint_as_float(r2[1]); }
            if (fq == 0) atomicAdd(ssn + row, (unsigned long long)(sq * SS_SCALE));
            asm volatile("" ::: "memory");
        }
    }
};
struct EpiUp {
    static constexpr bool PERM = true, AFTER_DRAIN = false;
    bf16_t* O; const unsigned long long* ss; int ldc;
    __device__ __forceinline__ void operator()(const f32x4 (&acc)[2][2][4][2], const Unit& u, int wr, int wc, int fr, int fq) const {
        const int row0 = u.pm * BM + wr * 64 + fr; const int col0 = u.pn * BM + wc * 32 + 8 * fq;
        unsigned long long sv[8];
#pragma unroll
        for (int i = 0; i < 8; ++i) sv[i] = ss[row0 + (i >> 2) * HALF + (i & 3) * 16];
#pragma unroll
        for (int ai = 0; ai < 2; ++ai)
#pragma unroll
            for (int m = 0; m < 4; ++m) {
                const int row = row0 + ai * HALF + m * 16;
                const float rs = 1.0f / sqrtf((float)sv[ai * 4 + m] * (SS_INV / XD) + RMS_EPS);
#pragma unroll
                for (int bj = 0; bj < 2; ++bj) {
                    f32x4 v0 = acc[ai][bj][m][0] * rs, v1 = acc[ai][bj][m][1] * rs;
#pragma unroll
                    for (int e = 0; e < 4; ++e) { const float a = fmaxf(v0[e], 0.f), b = fmaxf(v1[e], 0.f); v0[e] = a * a; v1[e] = b * b; }
                    u32x4 w; w.x = cvt_pk_bf16(v0[0], v0[1]); w.y = cvt_pk_bf16(v0[2], v0[3]); w.z = cvt_pk_bf16(v1[0], v1[1]); w.w = cvt_pk_bf16(v1[2], v1[3]);
                    __builtin_nontemporal_store(w, (u32x4*)(O + (size_t)row * ldc + col0 + bj * HALF));
                }
            }
    }
};

template <class Epi, class Sched, bool ALIGN_EPI = false, bool SP2 = false>
__device__ __forceinline__ void gemm_phase(PG8_LAS unsigned char* lds, const Gemm g, const Sched& S, const Epi& E) {
    int tid_ = threadIdx.x; asm volatile("" : "+v"(tid_));
    const int tid = tid_, wid = __builtin_amdgcn_readfirstlane(tid >> 6), lane = tid & 63, wr = wid >> 2, wc = wid & 3, fr = lane & 15, fq = lane >> 4;
    const int K = g.K, nt = K / BK;
    unsigned voffA[2], voffB[2];
#pragma unroll
    for (int i = 0; i < 2; ++i) { int R, C; stage_rc(tid * 16 + i * 8192, R, C); const int Rb = Epi::PERM ? ((R & ~31) + perm32(R & 31)) : R;
        voffA[i] = (unsigned)(R * K + C) * 2u; voffB[i] = (unsigned)(Rb * K + C) * 2u; }
    const size_t kstep = (size_t)(BK * 2);
    const size_t hstep = (size_t)HALF * K * 2;
    const size_t tstep = 2 * hstep;
    const unsigned ldsw = (unsigned)wid * 1024u;
    const int aoff = lds_byte(wr * 64 + fr, fq * 8), boff = lds_byte(wc * 32 + fr, fq * 8);
#define PG8_SA(b, h) (((b) * 2 + (h)) * HTB)
#define PG8_SB(b, h) ((4 + (b) * 2 + (h)) * HTB)
#define PG8_STAGE(bufoff, gbase, voff) do { _Pragma("unroll") for (int _i = 0; _i < 2; ++_i) \
        __builtin_amdgcn_global_load_lds((const unsigned*)((const char*)(gbase) + (voff)[_i]), (PG8_LAS unsigned*)(lds + (bufoff) + ldsw + _i * 8192), 16, 0, 0); } while (0)
#define PG8_LDA(dst, b, h) do { _Pragma("unroll") for (int m = 0; m < 4; ++m) _Pragma("unroll") for (int k = 0; k < 2; ++k) dst[m][k] = *(const PG8_LAS bf16x8*)(lds + PG8_SA(b, h) + aoff + m * 2048 + k * 1024); } while (0)
#define PG8_LDB(dst, b, h) do { _Pragma("unroll") for (int n = 0; n < 2; ++n) _Pragma("unroll") for (int k = 0; k < 2; ++k) dst[n][k] = *(const PG8_LAS bf16x8*)(lds + PG8_SB(b, h) + boff + n * 2048 + k * 1024); } while (0)
#define PG8_MMA(ai, bj, At, Bt) do { __builtin_amdgcn_s_setprio(1); _Pragma("unroll") for (int m = 0; m < 4; ++m) _Pragma("unroll") for (int n = 0; n < 2; ++n) _Pragma("unroll") for (int k = 0; k < 2; ++k) \
        acc[ai][bj][m][n] = __builtin_amdgcn_mfma_f32_16x16x32_bf16(Bt[n][k], At[m][k], acc[ai][bj][m][n], 0, 0, 0); __builtin_amdgcn_s_setprio(0); } while (0)
#define PG8_WAIT_V(n) asm volatile("s_waitcnt vmcnt(" #n ")" ::: "memory")
#define PG8_WAIT_L(n) asm volatile("s_waitcnt lgkmcnt(" #n ")" ::: "memory")
#define PG8_BAR __builtin_amdgcn_s_barrier()
#define PG8_SCHED __builtin_amdgcn_sched_barrier(0)
    Unit cur, nxt; int ui = 0;
    if (!S.next(0, cur)) return;
    f32x4 acc[2][2][4][2];
#pragma unroll
    for (int a = 0; a < 2; ++a)
#pragma unroll
        for (int b = 0; b < 2; ++b)
#pragma unroll
            for (int m = 0; m < 4; ++m)
#pragma unroll
                for (int n = 0; n < 2; ++n) acc[a][b][m][n] = (f32x4){0.f, 0.f, 0.f, 0.f};
    bf16x8 At[4][2], B0[2][2], B1[2][2];
    const char* cA = (const char*)g.A + (size_t)cur.pm * tstep; const char* cB = (const char*)g.Bt + (size_t)cur.pn * tstep;
    S.a_ready(cur);
    if constexpr (SP2) {
        PG8_STAGE(PG8_SB(0, 0), cB, voffB); PG8_STAGE(PG8_SB(0, 1), cB + hstep, voffB); PG8_STAGE(PG8_SA(0, 0), cA, voffA); PG8_STAGE(PG8_SA(0, 1), cA + hstep, voffA);
        if (wr == 1) PG8_BAR;
        PG8_WAIT_V(2); PG8_BAR;
        PG8_STAGE(PG8_SB(1, 0), cB + kstep, voffB); PG8_STAGE(PG8_SA(1, 0), cA + kstep, voffA); PG8_STAGE(PG8_SB(1, 1), cB + hstep + kstep, voffB);
        PG8_WAIT_V(6); PG8_BAR;
    } else {
        PG8_STAGE(PG8_SB(0, 0), cB, voffB); PG8_STAGE(PG8_SA(0, 0), cA, voffA); PG8_STAGE(PG8_SB(0, 1), cB + hstep, voffB); PG8_STAGE(PG8_SA(0, 1), cA + hstep, voffA);
        if (wr == 1) PG8_BAR;
        PG8_WAIT_V(4); PG8_BAR;
        PG8_STAGE(PG8_SB(1, 0), cB + kstep, voffB); PG8_STAGE(PG8_SA(1, 0), cA + kstep, voffA); PG8_STAGE(PG8_SB(1, 1), cB + hstep + kstep, voffB);
        PG8_WAIT_V(6); PG8_BAR;
    }
    for (;;) {
        const bool has_next = S.next(ui + 1, nxt);
        const char* nA = has_next ? (const char*)g.A + (size_t)nxt.pm * tstep : cA; const char* nB = has_next ? (const char*)g.Bt + (size_t)nxt.pn * tstep : cB;
        for (int t = 0; t < nt; t += 2) {
            const bool last = (t == nt - 2);
            const char* a1 = cA + (size_t)(t + 1) * kstep;
            const char* a2 = last ? nA : cA + (size_t)(t + 2) * kstep; const char* b2 = last ? nB : cB + (size_t)(t + 2) * kstep;
            const char* a3 = a2 + kstep; const char* b3 = b2 + kstep;
            if (last && has_next) S.a_ready(nxt);
            if constexpr (SP2) {
            PG8_LDB(B0, 0, 0); PG8_LDB(B1, 0, 1); PG8_SCHED; PG8_LDA(At, 0, 0); PG8_STAGE(PG8_SA(1, 1), a1 + hstep, voffA);
            PG8_WAIT_V(8); PG8_WAIT_L(0); PG8_BAR; PG8_MMA(0, 0, At, B0); PG8_MMA(0, 1, At, B1); PG8_BAR; PG8_SCHED;
            PG8_LDA(At, 0, 1); PG8_STAGE(PG8_SB(0, 0), b2, voffB); PG8_STAGE(PG8_SB(0, 1), b2 + hstep, voffB); PG8_STAGE(PG8_SA(0, 0), a2, voffA);
            PG8_WAIT_V(8); PG8_WAIT_L(0); PG8_BAR; PG8_MMA(1, 0, At, B0); PG8_MMA(1, 1, At, B1); PG8_BAR; PG8_SCHED;
            PG8_LDB(B0, 1, 0); PG8_LDB(B1, 1, 1); PG8_SCHED; PG8_LDA(At, 1, 0); PG8_STAGE(PG8_SA(0, 1), a2 + hstep, voffA);
            PG8_WAIT_V(8); PG8_WAIT_L(0); PG8_BAR; PG8_MMA(0, 0, At, B0); PG8_MMA(0, 1, At, B1); PG8_BAR; PG8_SCHED;
            PG8_LDA(At, 1, 1); PG8_STAGE(PG8_SB(1, 0), b3, voffB); PG8_STAGE(PG8_SB(1, 1), b3 + hstep, voffB); PG8_STAGE(PG8_SA(1, 0), a3, voffA);
            PG8_WAIT_V(8); PG8_WAIT_L(0); PG8_BAR; PG8_MMA(1, 0, At, B0); PG8_MMA(1, 1, At, B1); PG8_BAR; PG8_SCHED;
            } else {
            PG8_LDB(B0, 0, 0); PG8_SCHED; PG8_LDA(At, 0, 0); PG8_STAGE(PG8_SA(1, 1), a1 + hstep, voffA);
            PG8_WAIT_L(8); PG8_BAR; PG8_WAIT_L(0); PG8_MMA(0, 0, At, B0); PG8_BAR; PG8_SCHED;
            PG8_LDB(B1, 0, 1); PG8_STAGE(PG8_SB(0, 0), b2, voffB);
            PG8_BAR; PG8_WAIT_L(0); PG8_MMA(0, 1, At, B1); PG8_BAR;
            PG8_LDA(At, 0, 1); PG8_STAGE(PG8_SA(0, 0), a2, voffA);
            PG8_BAR; PG8_WAIT_L(0); PG8_MMA(1, 0, At, B0); PG8_BAR; PG8_SCHED;
            PG8_STAGE(PG8_SB(0, 1), b2 + hstep, voffB);
            PG8_WAIT_V(6); PG8_BAR; PG8_MMA(1, 1, At, B1); PG8_BAR;
            PG8_LDB(B0, 1, 0); PG8_SCHED; PG8_LDA(At, 1, 0); PG8_STAGE(PG8_SA(0, 1), a2 + hstep, voffA);
            PG8_WAIT_L(8); PG8_BAR; PG8_WAIT_L(0); PG8_MMA(0, 0, At, B0); PG8_BAR; PG8_SCHED;
            PG8_LDB(B1, 1, 1); PG8_STAGE(PG8_SB(1, 0), b3, voffB);
            PG8_BAR; PG8_WAIT_L(0); PG8_MMA(0, 1, At, B1); PG8_BAR;
            PG8_LDA(At, 1, 1); PG8_STAGE(PG8_SA(1, 0), a3, voffA);
            PG8_BAR; PG8_WAIT_L(0); PG8_MMA(1, 0, At, B0); PG8_BAR; PG8_SCHED;
            PG8_STAGE(PG8_SB(1, 1), b3 + hstep, voffB);
            PG8_WAIT_V(6); PG8_BAR; PG8_MMA(1, 1, At, B1); PG8_BAR;
            }
        }
        if constexpr (ALIGN_EPI) { if (wr == 0) PG8_BAR; }
        if constexpr (!Epi::AFTER_DRAIN) { E(acc, cur, wr, wc, fr, fq); S.done(cur); }
        if (!has_next) break;
#pragma unroll
        for (int a = 0; a < 2; ++a)
#pragma unroll
            for (int b = 0; b < 2; ++b)
#pragma unroll
                for (int m = 0; m < 4; ++m)
#pragma unroll
                    for (int n = 0; n < 2; ++n) acc[a][b][m][n] = (f32x4){0.f, 0.f, 0.f, 0.f};
        cur = nxt; cA = nA; cB = nB; ++ui;
        if constexpr (ALIGN_EPI) { if (wr == 1) PG8_BAR; }
    }
    PG8_WAIT_V(0);
    if constexpr (!ALIGN_EPI) { if (wr == 0) PG8_BAR; }
    PG8_BAR;
    if constexpr (Epi::AFTER_DRAIN) { E.fused(acc, cur, wr, wc, fr, fq, lds, wid, lane); S.done(cur); }
#undef PG8_SA
#undef PG8_SB
#undef PG8_STAGE
#undef PG8_LDA
#undef PG8_LDB
#undef PG8_MMA
#undef PG8_WAIT_V
#undef PG8_WAIT_L
#undef PG8_BAR
#undef PG8_SCHED
}
}

namespace mk {
using pg8::bf16_t; using pg8::bf16x8; using pg8::f32x4; using pg8::u32x4; using pg8::LDQ; using pg8::RMS_EPS; using pg8::SS_SCALE; using pg8::SS_INV;
typedef float f32x16 __attribute__((ext_vector_type(16)));
typedef short s16x4 __attribute__((ext_vector_type(4)));
typedef short v4i16_t __attribute__((ext_vector_type(4)));
typedef unsigned u32x2 __attribute__((ext_vector_type(2)));
#define LAS __attribute__((address_space(3)))

constexpr int NB = 2, T = 8192, M = NB * T, D = 2048, FF = 8192, NLAYER = 4;
constexpr int QOFF = 0, KOFF = 2048, VOFF = 2304, QIOFF = 2560, KIOFF = 3584;
constexpr int SW = 8196;
constexpr float LOG2E = 1.4426950408889634f, C2 = 0.125f * LOG2E;
constexpr size_t MiB = 1u << 20;
constexpr size_t WS_SS = 0, WS_BAR = 1536 * 1024, WS_ROPE = 2 * MiB, WS_WI = 3 * MiB, WS_WIN = 4 * MiB, WS_WOUT = 49 * MiB, WS_WUP = 81 * MiB, WS_WDN = 209 * MiB;
constexpr size_t WS_XB = 340 * MiB, WS_QKV = 404 * MiB, WS_ATT = 524 * MiB, WS_H = 588 * MiB, WS_END = 848 * MiB;
constexpr int LDS_BYTES = 147968, WAVE_LDS = 18432;
constexpr int NPHASE = 1 + NLAYER * 5 + 1 + 1;

__host__ __device__ __forceinline__ size_t win_off(int l) { return WS_WIN + (size_t)(l == 0 ? 0 : l == 1 ? 10 : l == 2 ? 25 : 35) * MiB; }
__device__ __forceinline__ int crow(int r, int hi) { return (r & 3) + 8 * (r >> 2) + 4 * hi; }
__device__ __forceinline__ float wave_sum(float v) {
#pragma unroll
    for (int o = 1; o < 64; o <<= 1) v += __shfl_xor(v, o);
    return v;
}
__device__ __forceinline__ unsigned f2bf(float f) { unsigned u = __builtin_bit_cast(unsigned, f); return (u + 0x7fffu + ((u >> 16) & 1u)) >> 16; }
__device__ __forceinline__ unsigned pk2(float lo, float hi) { return f2bf(lo) | (f2bf(hi) << 16); }
__device__ __forceinline__ float ex2(float x) { return __builtin_amdgcn_exp2f(x); }
__device__ __forceinline__ float xhalf(float v, int hi) {
    const unsigned u = __float_as_uint(v); auto rr = __builtin_amdgcn_permlane32_swap(u, u, false, false); return __uint_as_float(hi ? rr[0] : rr[1]); }
__device__ __forceinline__ float vmax(float a, float b) { float r; asm("v_max_f32_e32 %0, %1, %2" : "=v"(r) : "v"(a), "v"(b)); return r; }
__device__ __forceinline__ float vmax3(float a, float b, float c) { float r; asm("v_max3_f32 %0, %1, %2, %3" : "=v"(r) : "v"(a), "v"(b), "v"(c)); return r; }
__device__ __forceinline__ float vrelu(float a) { return __builtin_bit_cast(float, max(__builtin_bit_cast(int, a), 0)); }
__device__ __forceinline__ s16x4 vtr(const LAS unsigned char* p) { return __builtin_bit_cast(s16x4, __builtin_amdgcn_ds_read_tr16_b64_v4i16((LAS v4i16_t*)p)); }

struct Args { const float* in[14]; float* out; unsigned char* ws; int ph_lo, ph_hi; };

__device__ __forceinline__ void tr_item(const float* W, const float* gain, int K, int N, int Npad, bf16_t* WT, int item, int lane) {
    const int nblk = Npad / 64, kb = item / nblk, nb = item % nblk, k0 = 64 * kb, n0 = 64 * nb;
    const int kr = lane >> 4, nc = lane & 15, n = n0 + 4 * nc; const bool ok = n < N;
    const float* src = W + (size_t)(k0 + 16 * kr) * N + n;
    f32x4 v[16];
#pragma unroll
    for (int i = 0; i < 16; ++i) v[i] = ok ? __builtin_nontemporal_load((const f32x4*)(src + (size_t)i * N)) : (f32x4){0.f, 0.f, 0.f, 0.f};
    if (gain) {
        const f32x4* gp = (const f32x4*)(gain + k0 + 16 * kr);
#pragma unroll
        for (int q = 0; q < 4; ++q) { const f32x4 gq = gp[q]; v[4 * q] *= gq.x; v[4 * q + 1] *= gq.y; v[4 * q + 2] *= gq.z; v[4 * q + 3] *= gq.w; }
    }
#pragma unroll
    for (int e = 0; e < 4; ++e) {
        u32x4 o0, o1;
        o0.x = pg8::cvt_pk_bf16(v[0][e], v[1][e]); o0.y = pg8::cvt_pk_bf16(v[2][e], v[3][e]); o0.z = pg8::cvt_pk_bf16(v[4][e], v[5][e]); o0.w = pg8::cvt_pk_bf16(v[6][e], v[7][e]);
        o1.x = pg8::cvt_pk_bf16(v[8][e], v[9][e]); o1.y = pg8::cvt_pk_bf16(v[10][e], v[11][e]); o1.z = pg8::cvt_pk_bf16(v[12][e], v[13][e]); o1.w = pg8::cvt_pk_bf16(v[14][e], v[15][e]);
        bf16_t* dst = WT + (size_t)(n + e) * K + k0 + 16 * kr;
        __builtin_nontemporal_store(o0, (u32x4*)dst); __builtin_nontemporal_store(o1, (u32x4*)(dst + 8));
    }
}
__device__ __forceinline__ void sincos_red(float angf, float& sn, float& cs) {
    const double TWO_PI = 6.283185307179586476925286766559;
    const double a = (double)angf; const double k = rint(a * (1.0 / TWO_PI)); const double r = fma(-k, TWO_PI, a); const double r2 = r * r;
    double s = 1.0, c = 1.0;
#pragma unroll
    for (int n = 14; n >= 1; --n) { s = 1.0 - s * r2 / (double)((2 * n) * (2 * n + 1)); c = 1.0 - c * r2 / (double)((2 * n - 1) * (2 * n)); }
    sn = (float)(s * r); cs = (float)c;
}
__device__ __forceinline__ void prologue(const Args& a, LAS unsigned char* lds, int gw, int NGW, int wave, int lane) {
    unsigned char* ws = a.ws;
    for (int mi = 0; mi < 16; ++mi) {
        const int l = mi >> 2, which = mi & 3, kind = l % 3, j = l / 3;
        const float* src; const float* gain = nullptr; int K, N, Np; bf16_t* dst;
        if (which == 0) { K = D; N = (kind == 1) ? 3664 : 2560; Np = (kind == 1) ? 3840 : 2560;
            src = (kind == 0 ? a.in[7] : kind == 1 ? a.in[10] : a.in[12]) + (size_t)j * D * N; gain = a.in[2] + l * D; dst = (bf16_t*)(ws + win_off(l)); }
        else if (which == 1) { K = D; N = D; Np = D; src = (kind == 0 ? a.in[9] : kind == 1 ? a.in[11] : a.in[13]) + (size_t)j * D * D; dst = (bf16_t*)(ws + WS_WOUT + (size_t)l * 8 * MiB); }
        else if (which == 2) { K = D; N = FF; Np = FF; src = a.in[4] + (size_t)l * D * FF; gain = a.in[3] + l * D; dst = (bf16_t*)(ws + WS_WUP + (size_t)l * 32 * MiB); }
        else { K = FF; N = D; Np = D; src = a.in[5] + (size_t)l * FF * D; dst = (bf16_t*)(ws + WS_WDN + (size_t)l * 32 * MiB); }
        if (which == 3 || (which == 2 && kind != 1)) continue;
        const int nitems = (K / 64) * (Np / 64);
        for (int it = gw; it < nitems; it += NGW) tr_item(src, gain, K, N, Np, dst, it, lane);
    }
    const float* x = a.in[0]; bf16_t* xb = (bf16_t*)(ws + WS_XB); unsigned long long* ss = (unsigned long long*)(ws + WS_SS);
    for (int row = gw; row < M; row += NGW) {
        const f32x4* xr = (const f32x4*)(x + (size_t)row * D) + lane; u32x2* o8 = (u32x2*)(xb + (size_t)row * D) + lane; float s = 0.f;
#pragma unroll
        for (int jj = 0; jj < 8; ++jj) { const f32x4 v = __builtin_nontemporal_load(xr + 64 * jj); s += (v.x * v.x + v.y * v.y) + (v.z * v.z + v.w * v.w); u32x2 w; w.x = pk2(v.x, v.y); w.y = pk2(v.z, v.w); o8[64 * jj] = w; }
        s = wave_sum(s);
        if (lane == 0) ss[row] = (unsigned long long)(s * SS_SCALE);
        if (lane >= 1 && lane <= 8) ss[(size_t)lane * M + row] = 0ull;
    }
    const int* pos = (const int*)a.in[1]; float* rope = (float*)(ws + WS_ROPE);
    const float invf[8] = {1.0f, 0.1939227432012558f, 0.03760603070259094f, 0.007292664609849453f, 0.0014142135623842478f, 0.00027424818836152554f, 5.3182957344688475e-05f, 1.0313385246263351e-05f};
    for (int e = gw * 64 + lane; e < M * 8; e += NGW * 64) {
        const int row = e >> 3, i = e & 7;
        float inv = invf[0];
#pragma unroll
        for (int q = 1; q < 8; ++q) inv = (i == q) ? invf[q] : inv;
        const float ang = (float)pos[row] * inv; float sn, cs; sincos_red(ang, sn, cs);
        rope[(size_t)row * 16 + i] = cs; rope[(size_t)row * 16 + 8 + i] = sn;
    }
}

template <bool HALF>
__device__ __forceinline__ void attn_tile(const LAS unsigned char* Kt, const LAS unsigned char* Vt, int vplane, bf16x8 (&qr)[4], int dbase, int kstride, unsigned lim,
                                          f32x16& o0, f32x16& o1, float& m, float& l, int r32, int hi, int vb, const bf16_t* qnext = nullptr, bool half_rt = false) {
    const float NINF = -__builtin_inff();
    f32x16 p0 = {}, p1 = {};
    __builtin_amdgcn_s_setprio(1);
#pragma unroll
    for (int ks = 0; ks < 4; ++ks) {
        const int ko_ = r32 * 128 + (((2 * ks + hi) ^ ((r32 >> 1) & 7)) * 16);
        const bf16x8 a0 = *(const LAS bf16x8*)(Kt + ko_);
        p0 = __builtin_amdgcn_mfma_f32_32x32x16_bf16(a0, qr[ks], p0, 0, 0, 0);
        if (!HALF && !half_rt) { const bf16x8 a1 = *(const LAS bf16x8*)(Kt + ko_ + 4096); p1 = __builtin_amdgcn_mfma_f32_32x32x16_bf16(a1, qr[ks], p1, 0, 0, 0); }
    }
    __builtin_amdgcn_s_setprio(0);
    if (qnext) {
#pragma unroll
        for (int ks = 0; ks < 4; ++ks) qr[ks] = *(const bf16x8*)(qnext + 16 * ks);
    }
    if (!HALF && half_rt) {
#pragma unroll
        for (int r = 0; r < 16; ++r) p1[r] = NINF;
    }
    { const int dtop = dbase + 4 * hi * kstride, dlow = dtop - ((HALF || half_rt) ? 31 : 63) * kstride;
      if (!__all(dlow >= 0 && (unsigned)dtop <= lim)) {
#pragma unroll
        for (int r = 0; r < 16; ++r) {
            const int d0 = dbase - kstride * ((r & 3) + 8 * (r >> 2)), d1 = d0 - 32 * kstride;
            p0[r] = ((unsigned)d0 <= lim) ? p0[r] : NINF;
            if (!HALF) p1[r] = ((unsigned)d1 <= lim) ? p1[r] : NINF;
        }
      } }
    float mx = NINF;
#pragma unroll
    for (int r = 0; r < 16; ++r) {
        p0[r] *= C2;
        if (!HALF) { p1[r] *= C2; mx = __builtin_fmaxf(__builtin_fmaxf(mx, p0[r]), p1[r]); } else mx = __builtin_fmaxf(mx, p0[r]);
    }
    mx = __builtin_fmaxf(mx, xhalf(mx, hi));
    if (__any(mx > m + 6.0f)) {
        const float mn = __builtin_fmaxf(m, mx), mu2 = (mn == NINF) ? 0.f : mn, alpha = ex2(m - mu2);
        m = mn; l *= alpha;
#pragma unroll
        for (int r = 0; r < 16; ++r) { o0[r] *= alpha; o1[r] *= alpha; }
    }
    const float mu = (m == NINF) ? 0.f : m;
    float ls = 0.f;
    bf16x8 pa[4];
#pragma unroll
    for (int gq = 0; gq < ((HALF || half_rt) ? 2 : 4); ++gq) {
        float e[8];
#pragma unroll
        for (int i = 0; i < 8; ++i) { const float x = (gq < 2) ? p0[8 * (gq & 1) + i] : p1[8 * (gq & 1) + i]; e[i] = ex2(x - mu); ls += e[i]; }
        u32x4 w; w.x = pg8::cvt_pk_bf16(e[0], e[1]); w.y = pg8::cvt_pk_bf16(e[2], e[3]); w.z = pg8::cvt_pk_bf16(e[4], e[5]); w.w = pg8::cvt_pk_bf16(e[6], e[7]);
        pa[gq] = __builtin_bit_cast(bf16x8, w);
    }
    l += ls;
    __builtin_amdgcn_s_setprio(1);
#pragma unroll
    for (int kk = 0; kk < ((HALF || half_rt) ? 2 : 4); ++kk) {
        const s16x4 lo0 = vtr(Vt + vb + kk * 1024), hi0 = vtr(Vt + vb + kk * 1024 + 512);
        const s16x4 lo1 = vtr(Vt + vb + vplane + kk * 1024), hi1 = vtr(Vt + vb + vplane + kk * 1024 + 512);
        const bf16x8 v0 = (bf16x8){lo0[0], lo0[1], lo0[2], lo0[3], hi0[0], hi0[1], hi0[2], hi0[3]};
        const bf16x8 v1 = (bf16x8){lo1[0], lo1[1], lo1[2], lo1[3], hi1[0], hi1[1], hi1[2], hi1[3]};
        o0 = __builtin_amdgcn_mfma_f32_32x32x16_bf16(v0, pa[kk], o0, 0, 0, 0);
        o1 = __builtin_amdgcn_mfma_f32_32x32x16_bf16(v1, pa[kk], o1, 0, 0, 0);
    }
    __builtin_amdgcn_s_setprio(0);
}
template <bool GATHER, int KS>
__device__ __forceinline__ void attn_run(LAS unsigned char* wl, const bf16_t* Kg, const bf16_t* Vg, bf16x8 (&qr)[4], int ntiles, int kstart, int kstride_,
                                         int D0, unsigned lim, f32x16& o0, f32x16& o1, float& m, float& l, int lane, bool probe_noload = false, bool last_half = false) {
    const int r32 = lane & 31, hi = lane >> 5; const int kstride = KS ? KS : kstride_;
    LAS unsigned char* Kl = wl; LAS unsigned char* Vl = wl + 8192; const LAS int* idx = (const LAS int*)(wl + 16384);
    u32x4 kreg[8], vreg[8];
#define MK_POS(slot) (GATHER ? idx[(slot)] : min(max(kstart + kstride * (slot), 0), T - 1))
    const int srow_ = lane >> 3, sc_ = lane & 7;
#define MK_LOAD_TILE(t_) do { \
    _Pragma("unroll") for (int i_ = 0; i_ < 8; ++i_) { const int p_ = MK_POS(64 * (t_) + 8 * i_ + srow_); \
      const bf16_t* rp_ = Kg + (size_t)p_ * LDQ + sc_ * 8; kreg[i_] = *(const u32x4*)rp_; vreg[i_] = *(const u32x4*)(rp_ + (VOFF - KOFF)); } } while (0)
#define MK_STORE_TILE() do { \
    _Pragma("unroll") for (int i_ = 0; i_ < 8; ++i_) { const int key_ = 8 * i_ + srow_; \
      *(LAS u32x4*)(Kl + key_ * 128 + ((sc_ ^ ((key_ >> 1) & 7)) * 16)) = kreg[i_]; \
      *(LAS u32x4*)(Vl + (sc_ >> 2) * 4096 + key_ * 64 + (sc_ & 3) * 16) = vreg[i_]; } } while (0)
    MK_LOAD_TILE(0); asm volatile("" ::: "memory"); MK_STORE_TILE(); asm volatile("" ::: "memory");
    const int vb = ((lane >> 4) & 1) * 32 + (lane & 3) * 8 + (4 * hi + ((lane & 15) >> 2)) * 64;
    int dbase = D0 - kstride * 4 * hi;
    for (int t = 0; t < ntiles; ++t) {
        if (t + 1 < ntiles && !probe_noload) MK_LOAD_TILE(t + 1);
        attn_tile<false>(Kl, Vl, 4096, qr, dbase, kstride, lim, o0, o1, m, l, r32, hi, vb, nullptr, last_half && t + 1 == ntiles);
        dbase -= 64 * kstride;
        asm volatile("" ::: "memory");
        if (t + 1 < ntiles) MK_STORE_TILE();
        asm volatile("" ::: "memory");
    }
#undef MK_POS
#undef MK_LOAD_TILE
#undef MK_STORE_TILE
}
__device__ __forceinline__ void attn_store(bf16_t* orow, const f32x16& o0, const f32x16& o1, float inv, int hi) {
#pragma unroll
    for (int rg = 0; rg < 4; ++rg) {
        u32x2 w0, w1;
        w0.x = pg8::cvt_pk_bf16(o0[4 * rg] * inv, o0[4 * rg + 1] * inv); w0.y = pg8::cvt_pk_bf16(o0[4 * rg + 2] * inv, o0[4 * rg + 3] * inv);
        w1.x = pg8::cvt_pk_bf16(o1[4 * rg] * inv, o1[4 * rg + 1] * inv); w1.y = pg8::cvt_pk_bf16(o1[4 * rg + 2] * inv, o1[4 * rg + 3] * inv);
        *(u32x2*)(orow + 8 * rg + 4 * hi) = w0; *(u32x2*)(orow + 32 + 8 * rg + 4 * hi) = w1;
    }
}

__device__ __forceinline__ void swa_phase(const bf16_t* qkv, const float* sinks, bf16_t* att, LAS unsigned char* wl, int gw, int NGW, int lane, bool probe = false) {
    const int r32 = lane & 31, hi = lane >> 5, qi = r32 >> 3, g = r32 & 7;
    for (int u = gw; u < NB * 4 * (T / 4); u += NGW) {
        const int j = u % (T / 4), kvh = (u / (T / 4)) & 3, b = u / (T);
        const int t0 = 4 * j, tq = t0 + qi; const size_t rb = (size_t)b * T;
        bf16x8 qr[4];
        const bf16_t* qp = qkv + (rb + tq) * LDQ + QOFF + (kvh * 8 + g) * 64 + 8 * hi;
#pragma unroll
        for (int ks = 0; ks < 4; ++ks) qr[ks] = *(const bf16x8*)(qp + 16 * ks);
        const float sk = sinks[kvh * 8 + g] * LOG2E;
        f32x16 o0 = {}, o1 = {}; float m = sk, l = 0.f;
        const int kstart = t0 - 128;
        attn_run<false, 1>(wl, qkv + rb * LDQ + KOFF + kvh * 64, qkv + rb * LDQ + VOFF + kvh * 64, qr, 3, kstart, 1, tq - kstart, (unsigned)min(127, tq), o0, o1, m, l, lane, probe);
        l += __shfl_xor(l, 32); l += ex2(sk - m);
        if (!probe || l == 123.456f) attn_store(att + (rb + tq) * D + (kvh * 8 + g) * 64, o0, o1, 1.0f / l, hi);
    }
}
__device__ __forceinline__ void swa_phase_wg(const bf16_t* qkv, const float* sinks, bf16_t* att, LAS unsigned char* lds, int bid, int G, int tid, int wave, int lane) {
    constexpr int WROWS = 160, KIMG = WROWS * 128, VPL = WROWS * 64, BUF = KIMG + 2 * VPL, NBLK = T / 32, NU = NB * 4 * NBLK;
    const int r32 = lane & 31, hi = lane >> 5, qi = r32 >> 3, g = r32 & 7;
    const int vb = ((lane >> 4) & 1) * 32 + (lane & 3) * 8 + (4 * hi + ((lane & 15) >> 2)) * 64;
    u32x4 st[5];
#define SW_LOAD(u_) do { const int blk_ = (u_) % NBLK, kvh_ = ((u_) / NBLK) & 3, b_ = (u_) / (4 * NBLK); const int ws_ = 32 * blk_ - 128; const bf16_t* base_ = qkv + (size_t)b_ * T * LDQ + kvh_ * 64; \
    _Pragma("unroll") for (int i_ = 0; i_ < 5; ++i_) { const int id_ = tid + 512 * i_, row_ = id_ >> 4, c_ = id_ & 15; const int p_ = min(max(ws_ + row_, 0), T - 1); \
      st[i_] = *(const u32x4*)(base_ + (size_t)p_ * LDQ + (c_ < 8 ? KOFF + c_ * 8 : VOFF + (c_ - 8) * 8)); } } while (0)
#define SW_STORE(buf_) do { _Pragma("unroll") for (int i_ = 0; i_ < 5; ++i_) { const int id_ = tid + 512 * i_, row_ = id_ >> 4, c_ = id_ & 15; \
      if (c_ < 8) *(LAS u32x4*)((buf_) + row_ * 128 + ((c_ ^ ((row_ >> 1) & 7)) * 16)) = st[i_]; \
      else *(LAS u32x4*)((buf_) + KIMG + ((c_ - 8) >> 2) * VPL + row_ * 64 + ((c_ - 8) & 3) * 16) = st[i_]; } } while (0)
    int u = bid; if (u >= NU) return;
    SW_LOAD(u); SW_STORE(lds); __syncthreads();
    int pb = 0;
    for (; u < NU; u += G) {
        const int un = u + G; const bool has_next = un < NU;
        const int blk = u % NBLK, kvh = (u / NBLK) & 3, b = u / (4 * NBLK);
        const int t0 = 32 * blk, tq = t0 + 4 * wave + qi; const size_t rb = (size_t)b * T;
        bf16x8 qr[4];
        const bf16_t* qp = qkv + (rb + tq) * LDQ + QOFF + (kvh * 8 + g) * 64 + 8 * hi;
#pragma unroll
        for (int ks = 0; ks < 4; ++ks) qr[ks] = *(const bf16x8*)(qp + 16 * ks);
        if (has_next) SW_LOAD(un);
        const LAS unsigned char* buf = lds + pb * BUF;
        const float sk = sinks[kvh * 8 + g] * LOG2E;
        f32x16 o0 = {}, o1 = {}; float m = sk, l = 0.f;
        const unsigned lim = (unsigned)min(127, tq);
        int dbase = 128 + 4 * wave + qi - 4 * hi;
#pragma nounroll
        for (int tt = 0; tt < 2; ++tt) { attn_tile<false>(buf + 8192 * tt, buf + KIMG + 4096 * tt, VPL, qr, dbase, 1, lim, o0, o1, m, l, r32, hi, vb); dbase -= 64; asm volatile("" ::: "memory"); }
        attn_tile<true>(buf + 16384, buf + KIMG + 8192, VPL, qr, dbase, 1, lim, o0, o1, m, l, r32, hi, vb);
        l += __shfl_xor(l, 32); l += ex2(sk - m);
        attn_store(att + (rb + tq) * D + (kvh * 8 + g) * 64, o0, o1, 1.0f / l, hi);
        asm volatile("" ::: "memory");
        if (has_next) SW_STORE(lds + (pb ^ 1) * BUF);
        __syncthreads();
        pb ^= 1;
    }
#undef SW_LOAD
#undef SW_STORE
}
__device__ __forceinline__ void dil_phase(const bf16_t* qkv, bf16_t* att, LAS unsigned char* wl, int gw, int NGW, int lane) {
    const int r32 = lane & 31, hi = lane >> 5, qi = r32 >> 3, g = r32 & 7;
    for (int u = gw; u < NB * 4 * (T / 4); u += NGW) {
        const int res = u & 15, blk = (u >> 4) & 127, kvh = (u >> 11) & 3, b = u >> 13;
        const int t0 = 64 * blk + res, tq = t0 + 16 * qi; const size_t rb = (size_t)b * T;
        bf16x8 qr[4];
        const bf16_t* qp = qkv + (rb + tq) * LDQ + QOFF + (kvh * 8 + g) * 64 + 8 * hi;
#pragma unroll
        for (int ks = 0; ks < 4; ++ks) qr[ks] = *(const bf16x8*)(qp + 16 * ks);
        f32x16 o0 = {}, o1 = {}; float m = -__builtin_inff(), l = 0.f;
        const bf16_t* Kb = qkv + rb * LDQ + KOFF + kvh * 64; const bf16_t* Vb = qkv + rb * LDQ + VOFF + kvh * 64;
        attn_run<false, 1>(wl, Kb, Vb, qr, 3, t0 - 128, 1, tq - (t0 - 128), (unsigned)min(128, tq), o0, o1, m, l, lane);
        attn_run<false, 4>(wl, Kb, Vb, qr, 3, t0 - 512, 4, tq - (t0 - 512), (unsigned)min(512, tq), o0, o1, m, l, lane, false, true);
        attn_run<false, 16>(wl, Kb, Vb, qr, 3, t0 - 2048, 16, tq - (t0 - 2048), (unsigned)min(2048, tq), o0, o1, m, l, lane, false, true);
        l += __shfl_xor(l, 32);
        attn_store(att + (rb + tq) * D + (kvh * 8 + g) * 64, o0, o1, 1.0f / l, hi);
    }
}
__device__ __forceinline__ size_t score_off(int b, int t) { return b == 0 ? (size_t)t * SW : (size_t)(T - 1 - t) * SW + ((T - t + 3) & ~3); }
__device__ __forceinline__ void indexer_phase(const bf16_t* qkv, const float* wi32, float* scores, int gw, int NGW, int lane, bool do_store = true) {
    const int r32 = lane & 31, hi = lane >> 5;
    for (int u = gw; u < NB * (T / 4); u += NGW) {
        const int b = u / (T / 4), jj = u % (T / 4), j = (b == 0) ? jj : (T / 4 - 1 - jj);
        const int t0 = 4 * j; const size_t rb = (size_t)b * T;
        bf16x8 aq[2][4]; float wr[2][16];
#pragma unroll
        for (int s = 0; s < 2; ++s) {
            const bf16_t* qp = qkv + (rb + t0 + 2 * s + (r32 >> 4)) * LDQ + QIOFF + (r32 & 15) * 64 + 8 * hi;
#pragma unroll
            for (int ks = 0; ks < 4; ++ks) aq[s][ks] = *(const bf16x8*)(qp + 16 * ks);
#pragma unroll
            for (int r = 0; r < 16; ++r) { const int row = crow(r, hi); wr[s][r] = wi32[(rb + t0 + 2 * s + (row >> 4)) * 16 + (row & 15)] * 0.03125f; }
        }
        const int nsub = (t0 + 4 + 31) / 32;
        const bf16_t* kbase = qkv + rb * LDQ + KIOFF + 8 * hi + (size_t)r32 * LDQ;
        bf16x8 kq[2][4];
#define MK_KLOAD(slot, sub_) do { const bf16_t* kp_ = kbase + (size_t)(32 * (sub_)) * LDQ; \
        _Pragma("unroll") for (int ks = 0; ks < 4; ++ks) kq[slot][ks] = *(const bf16x8*)(kp_ + 16 * ks); } while (0)
#define MK_KSTEP(slot, sub_) do { if ((sub_) < nsub) { \
            const int key = 32 * (sub_) + r32; \
            f32x16 acc0 = {}, acc1 = {}; \
            _Pragma("unroll") for (int ks = 0; ks < 4; ++ks) acc0 = __builtin_amdgcn_mfma_f32_32x32x16_bf16(aq[0][ks], kq[slot][ks], acc0, 0, 0, 0); \
            _Pragma("unroll") for (int ks = 0; ks < 4; ++ks) acc1 = __builtin_amdgcn_mfma_f32_32x32x16_bf16(aq[1][ks], kq[slot][ks], acc1, 0, 0, 0); \
            if ((sub_) + 2 < nsub) MK_KLOAD(slot, (sub_) + 2); \
            MK_KRED(acc0, 0); MK_KRED(acc1, 1); } } while (0)
#define MK_KRED(acc, s) do { \
            float pa = 0.f, pb = 0.f; \
            _Pragma("unroll") for (int r = 0; r < 8; ++r) { pa = fmaf(vrelu(acc[r]), wr[s][r], pa); pb = fmaf(vrelu(acc[8 + r]), wr[s][8 + r], pb); } \
            const float mine = hi ? pb : pa, other = hi ? pa : pb; \
            const float tot = mine + __shfl_xor(other, 32); \
            const int tq = t0 + 2 * s + hi; \
            if (key <= tq && (do_store || tot == 123.456f)) scores[score_off(b, tq) + key] = tot; } while (0)
        MK_KLOAD(0, 0); if (1 < nsub) MK_KLOAD(1, 1);
        for (int sub = 0; sub < nsub; sub += 2) { MK_KSTEP(0, sub); MK_KSTEP(1, sub + 1); }
#undef MK_KLOAD
#undef MK_KSTEP
#undef MK_KRED
    }
}
__device__ __forceinline__ void indexer_phase_wg(const bf16_t* qkv, const float* wi32, float* scores, LAS unsigned char* lds, int bid, int G, int tid, int wave, int lane) {
    const int r32 = lane & 31, hi = lane >> 5;
    constexpr int NBLK = T / 32;
    const int srow = tid >> 3, sc = tid & 7;
    for (int u = bid; u < NB * NBLK; u += G) {
        const int b = u / NBLK, jj = u % NBLK, j = (b == 0) ? jj : (NBLK - 1 - jj);
        const int t0 = 32 * j + 4 * wave; const size_t rb = (size_t)b * T;
        bf16x8 aq[2][4]; float wr[2][16];
#pragma unroll
        for (int s = 0; s < 2; ++s) {
            const bf16_t* qp = qkv + (rb + t0 + 2 * s + (r32 >> 4)) * LDQ + QIOFF + (r32 & 15) * 64 + 8 * hi;
#pragma unroll
            for (int ks = 0; ks < 4; ++ks) aq[s][ks] = *(const bf16x8*)(qp + 16 * ks);
#pragma unroll
            for (int r = 0; r < 16; ++r) { const int row = crow(r, hi); wr[s][r] = wi32[(rb + t0 + 2 * s + (row >> 4)) * 16 + (row & 15)] * 0.03125f; }
        }
        const int nstep = (32 * j + 32 + 127) >> 7;
        const bf16_t* kg = qkv + (rb + srow) * LDQ + KIOFF + sc * 8;
        const int sdst = srow * 128 + ((sc ^ ((srow >> 1) & 7)) * 16);
        const int lastrow = 32 * j + 31;
        u32x4 kreg0 = *(const u32x4*)kg, kreg1 = *(const u32x4*)(kg + (size_t)min(64, lastrow - srow) * LDQ);
        __syncthreads();
        *(LAS u32x4*)(lds + sdst) = kreg0; *(LAS u32x4*)(lds + 8192 + sdst) = kreg1;
        __syncthreads();
        for (int st = 0; st < nstep; ++st) {
            if (st + 1 < nstep) { const int r0 = 128 * (st + 1);
                kreg0 = *(const u32x4*)(kg + (size_t)min(r0, lastrow - srow) * LDQ); kreg1 = *(const u32x4*)(kg + (size_t)min(r0 + 64, lastrow - srow) * LDQ); }
            const LAS unsigned char* buf = lds + (st & 1) * 16384;
#pragma unroll
            for (int sub = 0; sub < 4; ++sub) {
                const int k0 = 128 * st + 32 * sub;
                {
                    const int key = k0 + r32, lrow = 32 * (sub & 1) + r32;
                    const LAS unsigned char* img = buf + (sub >> 1) * 8192;
                    bf16x8 kf[4];
#pragma unroll
                    for (int ks = 0; ks < 4; ++ks) kf[ks] = *(const LAS bf16x8*)(img + lrow * 128 + (((2 * ks + hi) ^ ((lrow >> 1) & 7)) * 16));
                    f32x16 acc0 = {}, acc1 = {};
#pragma unroll
                    for (int ks = 0; ks < 4; ++ks) acc0 = __builtin_amdgcn_mfma_f32_32x32x16_bf16(aq[0][ks], kf[ks], acc0, 0, 0, 0);
#pragma unroll
                    for (int ks = 0; ks < 4; ++ks) acc1 = __builtin_amdgcn_mfma_f32_32x32x16_bf16(aq[1][ks], kf[ks], acc1, 0, 0, 0);
#define MK_KRED2(acc, s) do { \
                    float pa = 0.f, pb = 0.f; \
                    _Pragma("unroll") for (int r = 0; r < 8; ++r) { pa = fmaf(vrelu(acc[r]), wr[s][r], pa); pb = fmaf(vrelu(acc[8 + r]), wr[s][8 + r], pb); } \
                    const float mine = hi ? pb : pa, other = hi ? pa : pb; \
                    const float tot = mine + xhalf(other, hi); \
                    const int tq = t0 + 2 * s + hi; \
                    if (key <= tq) __builtin_nontemporal_store(tot, scores + score_off(b, tq) + key); } while (0)
                    MK_KRED2(acc0, 0); MK_KRED2(acc1, 1);
#undef MK_KRED2
                }
            }
            asm volatile("" ::: "memory");
            if (st + 1 < nstep) { LAS unsigned char* nb = lds + ((st + 1) & 1) * 16384; *(LAS u32x4*)(nb + sdst) = kreg0; *(LAS u32x4*)(nb + 8192 + sdst) = kreg1; }
            __syncthreads();
        }
    }
}
__device__ __forceinline__ unsigned f2key(float f) { const unsigned u = __float_as_uint(f); return (u & 0x80000000u) ? ~u : (u | 0x80000000u); }
__device__ __forceinline__ unsigned suffix_incl(unsigned v, int lane) {
#pragma unroll
    for (int off = 1; off < 64; off <<= 1) { const unsigned o = __shfl_down(v, off); if (lane + off < 64) v += o; }
    return v;
}
template <int NBIN> __device__ __forceinline__ void hist_zero(LAS unsigned* hist, int lane) {
    for (int i = lane * 4; i < NBIN; i += 256) *(LAS u32x4*)(hist + i) = (u32x4){0u, 0u, 0u, 0u};
}
template <int BITS> __device__ __forceinline__ unsigned find_bin(const LAS unsigned* hist, unsigned& k, int lane) {
    constexpr int NBIN = 1 << BITS, PER = NBIN / 64;
    unsigned s = 0;
#pragma unroll 8
    for (int j = 0; j < PER; ++j) s += hist[PER * lane + ((j + lane) & (PER - 1))];
    const unsigned incl = suffix_incl(s, lane), excl = incl - s;
    const bool hit = (excl < k) && (k <= incl);
    const int Ls = __ffsll((unsigned long long)__ballot(hit)) - 1;
    const unsigned exclS = __shfl(excl, Ls);
    const unsigned h = (lane < PER) ? hist[PER * Ls + (lane & (PER - 1))] : 0u;
    const unsigned incl2 = suffix_incl(h, lane) + exclS, excl2 = incl2 - h;
    const bool hit2 = (lane < PER) && (excl2 < k) && (k <= incl2);
    const int js = __ffsll((unsigned long long)__ballot(hit2)) - 1;
    k -= __shfl(excl2, js);
    return (unsigned)(PER * Ls + js);
}
#define MK_HADD(p) __hip_atomic_fetch_add((p), 1u, __ATOMIC_RELAXED, __HIP_MEMORY_SCOPE_WORKGROUP)
template <int BITS, int SHIFT, bool PREFIX>
__device__ __forceinline__ unsigned radix_pass(LAS unsigned* hist, const float* srow, int n, unsigned prefix, unsigned& k, int lane) {
    constexpr int NBIN = 1 << BITS;
    hist_zero<NBIN>(hist, lane);
    for (int i = lane; i < n; i += 64) {
        const unsigned key = f2key(srow[i]);
        bool in = true; if (PREFIX) in = (key >> ((SHIFT + BITS) & 31)) == prefix;
        if (in) MK_HADD(hist + ((key >> SHIFT) & (NBIN - 1)));
    }
    return find_bin<BITS>(hist, k, lane);
}
__device__ __forceinline__ void select256(LAS unsigned char* wl, const float* srow, int n, int lane) {
    constexpr int CAP = 1024;
    LAS unsigned* hist = (LAS unsigned*)wl; LAS int* idx = (LAS int*)(wl + 16384);
    LAS unsigned* candk = (LAS unsigned*)wl; LAS int* candi = (LAS int*)(wl + 4096); LAS unsigned* hist2 = (LAS unsigned*)(wl + 8192);
    const unsigned long long lt = (1ull << lane) - 1ull;
    unsigned k = 256;
    const f32x4* srow4 = (const f32x4*)srow;
#define SEL_LOAD4(v_, i0_) do { _Pragma("unroll") for (int q = 0; q < 16; ++q) { const int i_ = (i0_) + 256 * q + 4 * lane; v_[q] = (i_ < n) ? srow4[i_ >> 2] : (f32x4){0.f, 0.f, 0.f, 0.f}; } } while (0)
    hist_zero<4096>(hist, lane);
    for (int i0 = 0; i0 < n; i0 += 4096) {
        f32x4 v[16]; SEL_LOAD4(v, i0);
#pragma unroll
        for (int q = 0; q < 16; ++q)
#pragma unroll
            for (int e = 0; e < 4; ++e) { const int i = i0 + 256 * q + 4 * lane + e; if (i < n) MK_HADD(hist + (f2key(v[q][e]) >> 20)); }
    }
    const unsigned b1 = find_bin<12>(hist, k, lane);
    unsigned run = 0, cc = 0;
    for (int i0 = 0; i0 < n; i0 += 4096) {
        f32x4 v[16]; SEL_LOAD4(v, i0);
#pragma unroll
        for (int q = 0; q < 16; ++q)
#pragma unroll
            for (int e = 0; e < 4; ++e) {
                const int i = i0 + 256 * q + 4 * lane + e; const bool in = i < n; const unsigned key = f2key(v[q][e]); const unsigned bin = key >> 20;
                const bool gt = in && bin > b1, eq = in && bin == b1;
                const unsigned long long bg = __ballot(gt), be = __ballot(eq);
                if (gt) { const unsigned pos = run + (unsigned)__popcll(bg & lt); if (pos < 256u) idx[pos] = i; }
                if (eq) { const unsigned pos = cc + (unsigned)__popcll(be & lt); if (pos < (unsigned)CAP) { candk[pos] = key; candi[pos] = i; } }
                run += (unsigned)__popcll(bg); cc += (unsigned)__popcll(be);
            }
    }
#undef SEL_LOAD4
    if (cc <= (unsigned)CAP) {
        hist_zero<1024>(hist2, lane);
        for (unsigned c = lane; c < cc; c += 64) MK_HADD(hist2 + ((candk[c] >> 10) & 1023u));
        const unsigned b2 = find_bin<10>(hist2, k, lane);
        hist_zero<1024>(hist2, lane);
        for (unsigned c = lane; c < cc; c += 64) { const unsigned key = candk[c]; if (((key >> 10) & 1023u) == b2) MK_HADD(hist2 + (key & 1023u)); }
        const unsigned b3 = find_bin<10>(hist2, k, lane);
        const unsigned Tl = (b2 << 10) | b3, need = k; const unsigned E = hist2[b3];
        for (unsigned c0 = 0; c0 < cc; c0 += 64) {
            const unsigned c = c0 + lane; const bool in = c < cc; const unsigned low = in ? (candk[c] & 0xFFFFFu) : 0u;
            const bool gt = in && low > Tl, eq = in && low == Tl;
            bool take = gt || eq;
            if (E != need) {
                unsigned rank = 0; const int myi = in ? candi[c] : 0;
                for (unsigned c2 = 0; c2 < cc; ++c2) rank += ((candk[c2] & 0xFFFFFu) == Tl && candi[c2] < myi) ? 1u : 0u;
                take = gt || (eq && rank < need);
            }
            const unsigned long long bt = __ballot(take); const unsigned pos = run + (unsigned)__popcll(bt & lt);
            if (take && pos < 256u) idx[pos] = candi[c];
            run += (unsigned)__popcll(bt);
        }
    } else {
        unsigned k2 = 256;
        const unsigned c1 = radix_pass<12, 20, false>(hist, srow, n, 0u, k2, lane);
        const unsigned c2 = radix_pass<10, 10, true>(hist, srow, n, c1, k2, lane);
        const unsigned c3 = radix_pass<10, 0, true>(hist, srow, n, (c1 << 10) | c2, k2, lane);
        const unsigned Tk = (c1 << 20) | (c2 << 10) | c3, need = k2;
        unsigned r2 = 0, eqrun = 0;
        for (int i0 = 0; i0 < n; i0 += 64) {
            const int i = i0 + lane; const bool in = i < n; const unsigned key = in ? f2key(srow[i]) : 0u;
            const bool gt = in && key > Tk, eq = in && key == Tk;
            const unsigned long long beq = __ballot(eq); const unsigned eqr = eqrun + (unsigned)__popcll(beq & lt);
            const bool take = gt || (eq && eqr < need);
            const unsigned long long bt = __ballot(take); const unsigned pos = r2 + (unsigned)__popcll(bt & lt);
            if (take && pos < 256u) idx[pos] = i;
            r2 += (unsigned)__popcll(bt); eqrun += (unsigned)__popcll(beq);
        }
    }
}
__device__ __forceinline__ void dsa_select_phase(const float* scores, int* idxg, LAS unsigned char* wl, int gw, int NGW, int lane) {
    LAS int* idx = (LAS int*)(wl + 16384);
    for (int u = gw; u < M; u += NGW) {
        const int b = u / T, tt = u % T, t = ((tt >> 11) & 1) ? ((tt & ~2047) + 2047 - (tt & 2047)) : tt;
        const int n = t + 1;
        const float* srow = scores + score_off(b, t);
        if (n <= 256) { for (int i = lane; i < 256; i += 64) idx[i] = (i < n) ? i : 0; }
        else select256(wl, srow, n, lane);
        asm volatile("" ::: "memory");
        *(u32x4*)(idxg + ((size_t)b * T + t) * 256 + lane * 4) = *(const LAS u32x4*)(idx + lane * 4);
        asm volatile("" ::: "memory");
    }
}
__device__ __forceinline__ void dsa_attn_phase(const bf16_t* qkv, const int* idxg, bf16_t* att, LAS unsigned char* wl, int bid, int G, int wave, int lane) {
    const int r32 = lane & 31, hi = lane >> 5, g = r32 & 7;
    LAS int* idx = (LAS int*)(wl + 16384);
    int u0, u1, du;
    if ((G & 7) == 0) { const int x = bid & 7; u0 = x * T + (bid >> 3) * 8 + wave; u1 = (x + 1) * T; du = G; }
    else { u0 = bid * 8 + wave; u1 = 8 * T; du = G * 8; }
    for (int u = u0; u < u1; u += du) {
        const int x = u / T, t = u % T, b = x >> 2, kvh = x & 3;
        const size_t rb = (size_t)b * T; const int count = min(256, t + 1), ntiles = (count + 63) >> 6;
        *(LAS u32x4*)(idx + lane * 4) = *(const u32x4*)(idxg + (rb + t) * 256 + lane * 4);
        bf16x8 qr[4];
        const bf16_t* qp = qkv + (rb + t) * LDQ + QOFF + (kvh * 8 + g) * 64 + 8 * hi;
#pragma unroll
        for (int ks = 0; ks < 4; ++ks) qr[ks] = *(const bf16x8*)(qp + 16 * ks);
        asm volatile("" ::: "memory");
        f32x16 o0 = {}, o1 = {}; float m = -__builtin_inff(), l = 0.f;
        attn_run<true, 1>(wl, qkv + rb * LDQ + KOFF + kvh * 64, qkv + rb * LDQ + VOFF + kvh * 64, qr, ntiles, 0, 1, count - 1, 0x7fffffffu, o0, o1, m, l, lane);
        l += __shfl_xor(l, 32);
        if (r32 < 8) attn_store(att + (rb + t) * D + (kvh * 8 + g) * 64, o0, o1, 1.0f / l, hi);
    }
}
__device__ __forceinline__ float xq16(float v, int qp) { const unsigned u = __float_as_uint(v); auto rr = __builtin_amdgcn_permlane16_swap(u, u, false, false); return __uint_as_float((qp & 1) ? rr[0] : rr[1]); }
__device__ __forceinline__ void dsa_tile16(const LAS unsigned char* Kt, const LAS unsigned char* Vt, bf16x8 (&q16)[2], int slot0, int count,
                                           f32x4 (&o)[4], float& m, float& l, int c16, int qp, int hi, int vb16, const bf16_t* qnext) {
    const float NINF = -__builtin_inff();
    f32x4 s[4];
    __builtin_amdgcn_s_setprio(1);
#pragma unroll
    for (int kb = 0; kb < 4; ++kb) {
        s[kb] = (f32x4){0.f, 0.f, 0.f, 0.f};
        const int key = 16 * kb + c16, sw = (key >> 1) & 7;
#pragma unroll
        for (int ks = 0; ks < 2; ++ks) {
            const bf16x8 a = *(const LAS bf16x8*)(Kt + key * 128 + (((4 * ks + qp) ^ sw) * 16));
            s[kb] = __builtin_amdgcn_mfma_f32_16x16x32_bf16(a, q16[ks], s[kb], 0, 0, 0);
        }
    }
    __builtin_amdgcn_s_setprio(0);
    if (qnext) {
#pragma unroll
        for (int ks = 0; ks < 2; ++ks) q16[ks] = *(const bf16x8*)(qnext + 32 * ks);
    }
    float mx = NINF;
#pragma unroll
    for (int kb = 0; kb < 4; ++kb)
#pragma unroll
        for (int i = 0; i < 4; ++i) s[kb][i] *= C2;
    if (slot0 + 64 > count) {
#pragma unroll
        for (int kb = 0; kb < 4; ++kb)
#pragma unroll
            for (int i = 0; i < 4; ++i) s[kb][i] = (slot0 + 16 * kb + 4 * qp + i < count) ? s[kb][i] : NINF;
    }
#pragma unroll
    for (int kb = 0; kb < 4; ++kb) mx = __builtin_fmaxf(__builtin_fmaxf(mx, __builtin_fmaxf(s[kb][0], s[kb][1])), __builtin_fmaxf(s[kb][2], s[kb][3]));
    mx = __builtin_fmaxf(mx, xq16(mx, qp)); mx = __builtin_fmaxf(mx, xhalf(mx, hi));
    if (__any(mx > m + 6.0f)) {
        const float mn = __builtin_fmaxf(m, mx), mu2 = (mn == NINF) ? 0.f : mn, alpha = ex2(m - mu2);
        m = mn; l *= alpha;
#pragma unroll
        for (int db = 0; db < 4; ++db) o[db] *= alpha;
    }
    const float mu = (m == NINF) ? 0.f : m;
    float ls = 0.f;
#pragma unroll
    for (int kb = 0; kb < 4; ++kb)
#pragma unroll
        for (int i = 0; i < 4; ++i) { s[kb][i] = ex2(s[kb][i] - mu); ls += s[kb][i]; }
    l += ls;
    bf16x8 pb[2];
#pragma unroll
    for (int s2 = 0; s2 < 2; ++s2) { u32x4 w;
        w.x = pg8::cvt_pk_bf16(s[2 * s2][0], s[2 * s2][1]); w.y = pg8::cvt_pk_bf16(s[2 * s2][2], s[2 * s2][3]);
        w.z = pg8::cvt_pk_bf16(s[2 * s2 + 1][0], s[2 * s2 + 1][1]); w.w = pg8::cvt_pk_bf16(s[2 * s2 + 1][2], s[2 * s2 + 1][3]);
        pb[s2] = __builtin_bit_cast(bf16x8, w); }
    __builtin_amdgcn_s_setprio(1);
#pragma unroll
    for (int db = 0; db < 4; ++db)
#pragma unroll
        for (int s2 = 0; s2 < 2; ++s2) {
            const LAS unsigned char* vp = Vt + (db >> 1) * 4096 + (db & 1) * 32 + s2 * 2048 + vb16;
            const s16x4 lo = vtr(vp), hi4 = vtr(vp + 1024);
            const bf16x8 vf = (bf16x8){lo[0], lo[1], lo[2], lo[3], hi4[0], hi4[1], hi4[2], hi4[3]};
            o[db] = __builtin_amdgcn_mfma_f32_16x16x32_bf16(vf, pb[s2], o[db], 0, 0, 0);
        }
    __builtin_amdgcn_s_setprio(0);
}
__device__ __forceinline__ void dsa_attn_phase3(const bf16_t* qkv, const int* idxg, bf16_t* att, LAS unsigned char* wl, int bid, int G, int wave, int lane) {
    const int c16 = lane & 15, qp = lane >> 4, hi = lane >> 5, g = c16 & 7;
    LAS unsigned char* Kl = wl; LAS unsigned char* Vl = wl + 8192;
    LAS int* idxb0 = (LAS int*)(wl + 16384); LAS int* idxb1 = (LAS int*)(wl + 17408);
    const int srow_ = lane >> 3, sc_ = lane & 7;
    const int vb16 = (4 * qp + ((lane & 15) >> 2)) * 64 + (lane & 3) * 8;
    int u0, u1, du;
    if ((G & 7) == 0) { const int x = bid & 7; u0 = x * T + (bid >> 3) * 8 + wave; u1 = (x + 1) * T; du = G; }
    else { u0 = bid * 8 + wave; u1 = 8 * T; du = G * 8; }
    if (u0 >= u1) return;
    u32x4 kreg[8], vreg[8];
#define D3_LOAD(idp_, Kg_, t_) do { _Pragma("unroll") for (int i_ = 0; i_ < 8; ++i_) { const int p_ = (idp_)[64 * (t_) + 8 * i_ + srow_]; \
      const bf16_t* rp_ = (Kg_) + (size_t)p_ * LDQ + sc_ * 8; kreg[i_] = *(const u32x4*)rp_; vreg[i_] = *(const u32x4*)(rp_ + (VOFF - KOFF)); } } while (0)
#define D3_STORE() do { _Pragma("unroll") for (int i_ = 0; i_ < 8; ++i_) { const int key_ = 8 * i_ + srow_; \
      *(LAS u32x4*)(Kl + key_ * 128 + ((sc_ ^ ((key_ >> 1) & 7)) * 16)) = kreg[i_]; \
      *(LAS u32x4*)(Vl + (sc_ >> 2) * 4096 + key_ * 64 + (sc_ & 3) * 16) = vreg[i_]; } } while (0)
    int u = u0;
    int t = u % T, kvh = (u / T) & 3; size_t rb = (size_t)((u / T) >> 2) * T;
    const bf16_t* Kg = qkv + rb * LDQ + KOFF + kvh * 64;
    *(LAS u32x4*)(idxb0 + lane * 4) = *(const u32x4*)(idxg + (rb + t) * 256 + lane * 4);
    bf16x8 q16[2];
    { const bf16_t* qp_ = qkv + (rb + t) * LDQ + QOFF + (kvh * 8 + g) * 64 + 8 * qp;
#pragma unroll
      for (int ks = 0; ks < 2; ++ks) q16[ks] = *(const bf16x8*)(qp_ + 32 * ks); }
    asm volatile("" ::: "memory");
    D3_LOAD(idxb0, Kg, 0); asm volatile("" ::: "memory"); D3_STORE(); asm volatile("" ::: "memory");
    int cur = 0;
    for (;;) {
        const int un = u + du; const bool has_next = un < u1;
        const int tn = un % T, kvhn = (un / T) & 3; const size_t rbn = (size_t)((un / T) >> 2) * T;
        const bf16_t* Kgn = qkv + rbn * LDQ + KOFF + kvhn * 64;
        u32x4 idxn = {};
        if (has_next) idxn = *(const u32x4*)(idxg + (rbn + tn) * 256 + lane * 4);
        LAS int* idc = cur ? idxb1 : idxb0; LAS int* idn = cur ? idxb0 : idxb1;
        const int count = min(256, t + 1), ntiles = (count + 63) >> 6;
        f32x4 o[4] = {}; float m = -__builtin_inff(), l = 0.f;
        for (int tl = 0; tl < ntiles; ++tl) {
            if (tl + 1 < ntiles) D3_LOAD(idc, Kg, tl + 1);
            else if (has_next) { *(LAS u32x4*)(idn + lane * 4) = idxn; asm volatile("" ::: "memory"); D3_LOAD(idn, Kgn, 0); }
            const bf16_t* qnp = (tl + 1 == ntiles && has_next) ? qkv + (rbn + tn) * LDQ + QOFF + (kvhn * 8 + g) * 64 + 8 * qp : nullptr;
            dsa_tile16(Kl, Vl, q16, 64 * tl, count, o, m, l, c16, qp, hi, vb16, qnp);
            asm volatile("" ::: "memory");
            if (tl + 1 < ntiles || has_next) D3_STORE();
            asm volatile("" ::: "memory");
        }
        l += xq16(l, qp); l += xhalf(l, hi);
        if (c16 < 8) {
            const float inv = 1.0f / l; bf16_t* op = att + (rb + t) * D + (kvh * 8 + g) * 64 + 4 * qp;
#pragma unroll
            for (int db = 0; db < 4; ++db) { u32x2 w; w.x = pg8::cvt_pk_bf16(o[db][0] * inv, o[db][1] * inv); w.y = pg8::cvt_pk_bf16(o[db][2] * inv, o[db][3] * inv); *(u32x2*)(op + 16 * db) = w; }
        }
        if (!has_next) break;
        u = un; t = tn; kvh = kvhn; rb = rbn; Kg = Kgn; cur ^= 1;
    }
#undef D3_LOAD
#undef D3_STORE
}
__device__ __forceinline__ void dsa_fused_phase(const bf16_t* qkv, const float* scores, bf16_t* att, LAS unsigned char* wl, int gw, int NGW, int lane) {
    const int c16 = lane & 15, qp = lane >> 4, hi = lane >> 5, g = c16 & 7;
    LAS unsigned char* Kl = wl; LAS unsigned char* Vl = wl + 8192; LAS int* idx = (LAS int*)(wl + 16384);
    const int srow_ = lane >> 3, sc_ = lane & 7;
    const int vb16 = (4 * qp + ((lane & 15) >> 2)) * 64 + (lane & 3) * 8;
    for (int u = gw; u < M; u += NGW) {
        const int b = u / T, tt = u % T, t = ((tt >> 11) & 1) ? ((tt & ~2047) + 2047 - (tt & 2047)) : tt;
        const size_t rb = (size_t)b * T; const int n = t + 1, count = min(256, n), ntiles = (count + 63) >> 6;
        const float* srow = scores + score_off(b, t);
        if (n <= 256) { for (int i = lane; i < 256; i += 64) idx[i] = (i < n) ? i : 0; }
        else select256(wl, srow, n, lane);
        asm volatile("" ::: "memory");
        const bf16_t* Kg0 = qkv + rb * LDQ + KOFF;
        bf16x8 q16[2];
        { const bf16_t* qp_ = qkv + (rb + t) * LDQ + QOFF + g * 64 + 8 * qp;
#pragma unroll
          for (int ks = 0; ks < 2; ++ks) q16[ks] = *(const bf16x8*)(qp_ + 32 * ks); }
        u32x4 kreg[8], vreg[8];
#define DF_LOAD(Kg_, t_) do { _Pragma("unroll") for (int i_ = 0; i_ < 8; ++i_) { const int p_ = idx[64 * (t_) + 8 * i_ + srow_]; \
      const bf16_t* rp_ = (Kg_) + (size_t)p_ * LDQ + sc_ * 8; kreg[i_] = *(const u32x4*)rp_; vreg[i_] = *(const u32x4*)(rp_ + (VOFF - KOFF)); } } while (0)
#define DF_STORE() do { asm volatile("" ::: "memory"); _Pragma("unroll") for (int i_ = 0; i_ < 8; ++i_) { const int key_ = 8 * i_ + srow_; \
      *(LAS u32x4*)(Kl + key_ * 128 + ((sc_ ^ ((key_ >> 1) & 7)) * 16)) = kreg[i_]; \
      *(LAS u32x4*)(Vl + (sc_ >> 2) * 4096 + key_ * 64 + (sc_ & 3) * 16) = vreg[i_]; } asm volatile("" ::: "memory"); } while (0)
        DF_LOAD(Kg0, 0); DF_STORE();
        for (int kvh = 0; kvh < 4; ++kvh) {
            const bf16_t* Kg = Kg0 + kvh * 64;
            f32x4 o[4] = {}; float m = -__builtin_inff(), l = 0.f;
            for (int tl = 0; tl < ntiles; ++tl) {
                const bool last = tl + 1 == ntiles, nxt = last && kvh < 3;
                if (!last) DF_LOAD(Kg, tl + 1); else if (nxt) DF_LOAD(Kg + 64, 0);
                dsa_tile16(Kl, Vl, q16, 64 * tl, count, o, m, l, c16, qp, hi, vb16, nxt ? qkv + (rb + t) * LDQ + QOFF + ((kvh + 1) * 8 + g) * 64 + 8 * qp : nullptr);
                if (!last || nxt) DF_STORE();
            }
            l += xq16(l, qp); l += xhalf(l, hi);
            if (c16 < 8) {
                const float inv = 1.0f / l; bf16_t* op = att + (rb + t) * D + (kvh * 8 + g) * 64 + 4 * qp;
#pragma unroll
                for (int db = 0; db < 4; ++db) { u32x2 w; w.x = pg8::cvt_pk_bf16(o[db][0] * inv, o[db][1] * inv); w.y = pg8::cvt_pk_bf16(o[db][2] * inv, o[db][3] * inv); *(u32x2*)(op + 16 * db) = w; }
            }
        }
#undef DF_LOAD
#undef DF_STORE
        asm volatile("" ::: "memory");
    }
}
__device__ __forceinline__ void final_phase(float* out, const bf16_t* xbf, const unsigned long long* ss, const float* gfin, int gw, int NGW, int lane) {
    for (int row = gw; row < M; row += NGW) {
        const float rs = 1.0f / sqrtf((float)ss[row] * (SS_INV / D) + RMS_EPS);
        const u32x4* xr = (const u32x4*)(xbf + (size_t)row * D) + lane; f32x4* orow = (f32x4*)(out + (size_t)row * D); const f32x4* gr = (const f32x4*)gfin;
#pragma unroll
        for (int jj = 0; jj < 4; ++jj) {
            const u32x4 w = __builtin_nontemporal_load(xr + 64 * jj); const int c4 = 128 * jj + 2 * lane;
            const f32x4 g0 = gr[c4], g1 = gr[c4 + 1];
            f32x4 v0, v1;
            v0.x = __uint_as_float(w.x << 16); v0.y = __uint_as_float(w.x & 0xffff0000u); v0.z = __uint_as_float(w.y << 16); v0.w = __uint_as_float(w.y & 0xffff0000u);
            v1.x = __uint_as_float(w.z << 16); v1.y = __uint_as_float(w.z & 0xffff0000u); v1.z = __uint_as_float(w.w << 16); v1.w = __uint_as_float(w.w & 0xffff0000u);
            __builtin_nontemporal_store(v0 * rs * g0, orow + c4); __builtin_nontemporal_store(v1 * rs * g1, orow + c4 + 1);
        }
    }
}
#define XB_TMO      128
#define XB_XCNT(j)  (256  + 64 * (j))
#define XB_XSUB(j)  (1280 + 64 * (j))
#define XB_XGEN(j)  (2304 + 64 * (j))
#define XB_TOP      3328
#define XB_TOPGEN   3392
#define XCD_BAR_WORDS 3456
#define XB_SPIN_CAP (1u << 18)

__device__ __forceinline__ unsigned xb_ld(unsigned* p)              { return __hip_atomic_load(p, __ATOMIC_RELAXED, __HIP_MEMORY_SCOPE_AGENT); }
__device__ __forceinline__ unsigned xb_add(unsigned* p, unsigned v) { return __hip_atomic_fetch_add(p, v, __ATOMIC_RELAXED, __HIP_MEMORY_SCOPE_AGENT); }
__device__ __forceinline__ unsigned xb_xcc_id() { return (unsigned)__builtin_amdgcn_s_getreg((3 << 11) | 20) & 0xFu; }
#define XB_SPIN(cond, bar) do { unsigned _sp = 0; while (cond) { __builtin_amdgcn_s_sleep(1); \
    if ((++_sp & 255u) == 0u) { if (xb_ld(&(bar)[XB_TMO])) break; if (_sp > XB_SPIN_CAP) { atomicAdd(&(bar)[XB_TMO], 1u); break; } } } } while (0)

struct XcdBarrier {
    unsigned* bar; unsigned x;
    volatile LAS unsigned* st;
};

__device__ __forceinline__ XcdBarrier xcd_barrier_post(unsigned* bar, volatile LAS unsigned* st) {
    XcdBarrier b; b.bar = bar; b.x = xb_xcc_id(); b.st = st;
    if (threadIdx.x == 0) (void)xb_add(&bar[XB_XCNT(b.x)], 1u);
    return b;
}
__device__ __forceinline__ void xcd_barrier_complete(unsigned* bar, unsigned x, unsigned& nloc, unsigned& nx) {
    const unsigned G = gridDim.x * gridDim.y * gridDim.z;
    unsigned sum, cnt, mine, sp = 0u;
    for (;;) {
        sum = 0u; cnt = 0u; mine = 0u;
#pragma unroll
        for (unsigned j = 0; j < 16; ++j) { const unsigned c = xb_ld(&bar[XB_XCNT(j)]); sum += c; cnt += (c > 0u) ? 1u : 0u; mine = (j == x) ? c : mine; }
        if (sum == G) break;
        __builtin_amdgcn_s_sleep(1);
        if ((++sp & 255u) == 0u) { if (xb_ld(&bar[XB_TMO])) break; if (sp > XB_SPIN_CAP) { atomicAdd(&bar[XB_TMO], 1u); break; } }
    }
    nloc = mine > 0u ? mine : 1u; nx = cnt > 0u ? cnt : 1u;
}

__device__ __forceinline__ void xcd_barrier(const XcdBarrier& b) {
    asm volatile("s_waitcnt vmcnt(0)" ::: "memory");
    __syncthreads();
    if (threadIdx.x == 0) {
        unsigned* bar = b.bar;
        __builtin_amdgcn_s_waitcnt(0);
        unsigned nloc = b.st[0], nx = b.st[1];
        if (nloc == 0u) { xcd_barrier_complete(bar, b.x, nloc, nx); b.st[0] = nloc; b.st[1] = nx; }
        const unsigned old = xb_add(&bar[XB_XSUB(b.x)], 1u);
        const unsigned gen = old / nloc;
        if (old + 1u == (gen + 1u) * nloc) {
            __builtin_amdgcn_fence(__ATOMIC_RELEASE, "agent");
            asm volatile("s_waitcnt vmcnt(0)" ::: "memory");
            const unsigned og = xb_add(&bar[XB_TOP], 1u);
            const unsigned tg = og / nx;
            if (og + 1u == (tg + 1u) * nx) xb_add(&bar[XB_TOPGEN], 1u);
            else XB_SPIN(xb_ld(&bar[XB_TOPGEN]) == tg, bar);
            __builtin_amdgcn_fence(__ATOMIC_ACQUIRE, "agent");
            xb_add(&bar[XB_XGEN(b.x)], 1u);
            asm volatile("s_waitcnt vmcnt(0)" ::: "memory");
        } else {
            XB_SPIN(xb_ld(&bar[XB_XGEN(b.x)]) == gen, bar);
            __builtin_amdgcn_fence(__ATOMIC_ACQUIRE, "agent");
            asm volatile("s_waitcnt vmcnt(0)" ::: "memory");
        }
    }
    __syncthreads();
}

#ifndef REP_PRO
#define REP_PRO 1
#endif
#ifndef REP_IDX
#define REP_IDX 1
#endif
#ifndef REP_SWA
#define REP_SWA 1
#endif
#ifndef REP_DSA
#define REP_DSA 1
#endif
#ifndef REP_SEL
#define REP_SEL 1
#endif
#ifndef REP_GQKV
#define REP_GQKV 1
#endif
#ifndef REP_GUP
#define REP_GUP 1
#endif
#ifndef REP_DIL
#define REP_DIL 1
#endif
#ifndef PG8_SP2
#define PG8_SP2 true
#endif
#ifndef PG8_ALIGN
#define PG8_ALIGN true
#endif

__global__ void __launch_bounds__(512, 2) mega(Args a) {
    extern __shared__ __attribute__((aligned(16))) unsigned char lds_raw[];
    cg::grid_group grid = cg::this_grid();
    LAS unsigned char* lds = (LAS unsigned char*)lds_raw;
    const int tid = threadIdx.x, lane = tid & 63, wave = __builtin_amdgcn_readfirstlane(tid >> 6);
    const int G = gridDim.x, gw = blockIdx.x * 8 + wave, NGW = G * 8;
    LAS unsigned char* wl = lds + wave * WAVE_LDS;
    unsigned char* ws = a.ws;
    unsigned long long* ss = (unsigned long long*)(ws + WS_SS); const float* rope = (const float*)(ws + WS_ROPE); float* wi32 = (float*)(ws + WS_WI);
    bf16_t* xb = (bf16_t*)(ws + WS_XB); bf16_t* qkv = (bf16_t*)(ws + WS_QKV); bf16_t* att = (bf16_t*)(ws + WS_ATT); bf16_t* hid = (bf16_t*)(ws + WS_H); float* scores = (float*)(ws + WS_H); int* idxg = (int*)(ws + WS_XB);
    const int lo = a.ph_lo, hi = a.ph_hi;
    int ph = 0;
    volatile LAS unsigned* bst = (volatile LAS unsigned*)(lds + LDS_BYTES - 64);
    if (tid < 16) ((LAS unsigned*)(lds + LDS_BYTES - 64))[tid] = 0u;
    __syncthreads();
    XcdBarrier bar; bar.bar = (unsigned*)(ws + WS_BAR); bar.x = 0; bar.st = bst;
    if (hi - lo > 1) bar = xcd_barrier_post((unsigned*)(ws + WS_BAR), bst);
    bool first_sync = true;
#define PH_BEGIN if (ph >= lo && ph < hi) { int ln = threadIdx.x & 63; asm volatile("" : "+v"(ln));
#define PH_END   if (ph + 1 < hi) { if (first_sync) { grid.sync(); first_sync = false; } else xcd_barrier(bar); } } ++ph;

    PH_BEGIN
#ifndef SKIP_PRO
 for (int rep_ = 0; rep_ < REP_PRO; ++rep_) prologue(a, lds, gw, NGW, wave, ln);
#endif
 PH_END

    for (int L = 0; L < NLAYER; ++L) {
        const int kind = L % 3, jl = L / 3;
        const int NQ = (kind == 1) ? 3840 : 2560;
        const float* xin = (L == 0) ? a.in[0] : a.out;
        PH_BEGIN {
            pg8::Gemm g{xb, (const bf16_t*)(ws + win_off(L)), M, NQ, D}; pg8::StaticOrder S; S.init(M, NQ, G, (int)blockIdx.x);
            pg8::EpiQKV E{qkv, ss + (size_t)(2 * L) * M, rope, wi32};
#ifndef SKIP_GQKV
            for (int rep_ = 0; rep_ < REP_GQKV; ++rep_) pg8::gemm_phase<pg8::EpiQKV, pg8::StaticOrder, PG8_ALIGN, PG8_SP2>(lds, g, S, E);
#endif
            {
                const int nwg = (M / 256) * (NQ / 256), maxu = (nwg + G - 1) / G, rfull = nwg - (maxu - 1) * G;
                const bool all = rfull >= G; const int bidx = (int)blockIdx.x;
                if (all || bidx >= rfull) {
                    const int niw = (all ? G : G - rfull) * 8, iw = (all ? bidx : bidx - rfull) * 8 + wave;
                    for (int it = iw; it < (FF / 64) * (D / 64); it += niw) tr_item(a.in[5] + (size_t)L * FF * D, nullptr, FF, D, D, (bf16_t*)(ws + WS_WDN + (size_t)L * 32 * MiB), it, ln);
                    if (kind != 1) for (int it = iw; it < (D / 64) * (FF / 64); it += niw) tr_item(a.in[4] + (size_t)L * D * FF, a.in[3] + L * D, D, FF, FF, (bf16_t*)(ws + WS_WUP + (size_t)L * 32 * MiB), it, ln);
                }
            }
        } PH_END
        if (kind == 1) { PH_BEGIN
#ifndef SKIP_IDX
 for (int rep_ = 0; rep_ < REP_IDX; ++rep_) indexer_phase_wg(qkv, wi32, scores, lds, (int)blockIdx.x, G, (wave << 6) | ln, wave, ln);
#endif
 PH_END }
        PH_BEGIN {
#ifndef SKIP_SWA
            if (kind == 0) for (int rep_ = 0; rep_ < REP_SWA; ++rep_) swa_phase_wg(qkv, a.in[8] + jl * 32, att, lds, (int)blockIdx.x, G, (wave << 6) | ln, wave, ln);
#endif
#ifndef SKIP_DSA
            if (kind == 1) for (int rep_ = 0; rep_ < REP_DSA; ++rep_) dsa_fused_phase(qkv, scores, att, wl, gw, NGW, ln);
#endif
#ifndef SKIP_DIL
            if (kind == 2) for (int rep_ = 0; rep_ < REP_DIL; ++rep_) dil_phase(qkv, att, wl, gw, NGW, ln);
#endif
        } PH_END
        for (int st = 0; st < 3; ++st) {
            PH_BEGIN {
                if (st == 1) {
                    pg8::Gemm g{xb, (const bf16_t*)(ws + WS_WUP + (size_t)L * 32 * MiB), M, FF, D}; pg8::StaticOrder S; S.init(M, FF, G, (int)blockIdx.x);
                    pg8::EpiUp E{hid, ss + (size_t)(2 * L + 1) * M, FF};
#ifndef SKIP_GUP
                    for (int rep_ = 0; rep_ < REP_GUP; ++rep_) pg8::gemm_phase<pg8::EpiUp, pg8::StaticOrder, PG8_ALIGN, PG8_SP2>(lds, g, S, E);
#endif
                } else {
                    const bf16_t* Am = (st == 0) ? att : hid; const int Kd = (st == 0) ? D : FF;
                    const bf16_t* Bm = (st == 0) ? (const bf16_t*)(ws + WS_WOUT + (size_t)L * 8 * MiB) : (const bf16_t*)(ws + WS_WDN + (size_t)L * 32 * MiB);
                    pg8::Gemm g{Am, Bm, M, D, Kd}; pg8::StaticOrder S; S.init(M, D, G, (int)blockIdx.x);
                    const bool lastres = (st == 2 && L == NLAYER - 1);
                    pg8::EpiRes E{(st == 0) ? xin : a.out, lastres ? nullptr : a.out, xb, ss + (size_t)(2 * L + 1 + (st == 2 ? 1 : 0)) * M};
#ifndef SKIP_GRES
                    pg8::gemm_phase<pg8::EpiRes, pg8::StaticOrder, PG8_ALIGN, PG8_SP2>(lds, g, S, E);
#endif
                }
            } PH_END
        }
    }
#ifdef EXTRA_SYNCS
    if (hi - lo > 1) for (int i_ = 0; i_ < EXTRA_SYNCS; ++i_) xcd_barrier(bar);
#endif
    PH_BEGIN
#ifndef SKIP_FIN
 final_phase(a.out, xb, ss + (size_t)8 * M, a.in[6], gw, NGW, ln);
#endif
 PH_END
#undef PH_BEGIN
#undef PH_END
}
}

#ifndef MK_MULTI
#define MK_MULTI 0
#endif
extern "C" void kernel_launch(void* const* d_in, const int* in_sizes, int n_in, void* d_out, int out_size, void* d_ws, size_t ws_size, hipStream_t stream) {
    static int grid = 0;
    if (grid == 0) {
        if (n_in != 14 || ws_size < mk::WS_END) { fprintf(stderr, "kernel_launch: unexpected inputs (n_in %d, ws %zu)\n", n_in, ws_size); grid = -1; return; }
        int dev = 0, cus = 0, per_cu = 0;
        hipGetDevice(&dev); hipDeviceGetAttribute(&cus, hipDeviceAttributeMultiprocessorCount, dev);
        if (hipFuncSetAttribute((const void*)mk::mega, hipFuncAttributeMaxDynamicSharedMemorySize, mk::LDS_BYTES) != hipSuccess) { fprintf(stderr, "kernel_launch: hipFuncSetAttribute failed\n"); grid = -1; return; }
        if (hipOccupancyMaxActiveBlocksPerMultiprocessor(&per_cu, (const void*)mk::mega, 512, mk::LDS_BYTES) != hipSuccess || per_cu < 1) { fprintf(stderr, "kernel_launch: occupancy query gave %d\n", per_cu); per_cu = 1; }
        (void)hipGetLastError();
        grid = cus * per_cu;
        fprintf(stderr, "kernel_launch: grid %d (cus %d x %d)\n", grid, cus, per_cu);
    }
    if (grid < 0) return;
    mk::Args a{};
    for (int i = 0; i < 14; ++i) a.in[i] = (const float*)d_in[i];
    a.out = (float*)d_out; a.ws = (unsigned char*)d_ws;
    if (hipMemsetAsync((char*)d_ws + mk::WS_BAR, 0, 16384, stream) != hipSuccess) { fprintf(stderr, "kernel_launch: memset failed\n"); return; }
#if MK_MULTI
    for (int p = 0; p < mk::NPHASE; ++p) { a.ph_lo = p; a.ph_hi = p + 1; hipLaunchKernelGGL(mk::mega, dim3(grid), dim3(512), mk::LDS_BYTES, stream, a); }
#else
    a.ph_lo = 0; a.ph_hi = mk::NPHASE;
    void* args[] = {&a};
    hipError_t e = hipLaunchCooperativeKernel((const void*)mk::mega, dim3(grid), dim3(512), args, mk::LDS_BYTES, stream);
    if (e != hipSuccess) fprintf(stderr, "cooperative launch failed: %s (grid %d)\n", hipGetErrorString(e), grid);
#endif
}
```

```cpp
#include <hip/hip_runtime.h>
#include <hip/hip_cooperative_groups.h>
#include <cstdio>
#include <cstdint>
namespace cg = cooperative_groups;

namespace pg8 {
#define PG8_LAS __attribute__((address_space(3)))
typedef unsigned short bf16_t;
typedef short bf16x8 __attribute__((ext_vector_type(8)));
typedef float f32x4 __attribute__((ext_vector_type(4)));
typedef unsigned u32x4 __attribute__((ext_vector_type(4)));
constexpr int BM = 256, BK = 64, HALF = 128, HTB = HALF * BK * 2  , STAGE_BYTES = 8 * HTB, NXCD = 8, WGM = 4;

__host__ __device__ __forceinline__ int lds_byte(int r, int c) { const int st = (r >> 4) * 2 + (c >> 5), rr = r & 15, cc = c & 31, ob = rr * 64 + cc * 2; return st * 1024 + (ob ^ (((ob >> 9) & 1) << 5)); }
__host__ __device__ __forceinline__ void stage_rc(int b, int& R, int& C) { const int st = b / 1024, sb = b % 1024, swz = sb ^ (((sb >> 9) & 1) << 5); R = (st >> 1) * 16 + swz / 64; C = (st & 1) * 32 + (swz % 64) / 2; }
__host__ __device__ __forceinline__ int perm32(int rho) { const int n = rho >> 4, i = rho & 15; return 8 * (i >> 2) + 4 * n + (i & 3); }

struct Unit { int pm, pn; };
struct Gemm { const bf16_t* A; const bf16_t* Bt; int M, N, K; };

struct StaticOrder {
    int nM, nN, nwg, G, c;
    __host__ __device__ void init(int M, int N, int G_, int c_) { nM = M / BM; nN = N / BM; nwg = nM * nN; G = G_; c = c_; }
    __host__ __device__ bool next(int i, Unit& u) const {
        const long L = (long)i * G + c; if (L >= nwg) return false;
        int wgid = (int)L; { const int q = nwg / NXCD, r = nwg % NXCD, xcd = wgid % NXCD, off = wgid / NXCD; wgid = (xcd < r ? xcd * (q + 1) : r * (q + 1) + (xcd - r) * q) + off; }
        const int nig = WGM * nN, gid = wgid / nig, fm = gid * WGM, gsz = (nM - fm) < WGM ? (nM - fm) : WGM;
        u.pm = fm + ((wgid % nig) % gsz); u.pn = (wgid % nig) / gsz; return true;
    }
    __device__ __forceinline__ void a_ready(const Unit&) const {}
    __device__ __forceinline__ void done(const Unit&) const {}
};

__device__ __forceinline__ unsigned cvt_pk_bf16(float lo, float hi) { unsigned r; asm volatile("v_cvt_pk_bf16_f32 %0, %1, %2" : "=v"(r) : "v"(lo), "v"(hi)); return r; }

constexpr int XD = 2048;
constexpr int LDQ = 3840;
constexpr float RMS_EPS = 1e-5f;
constexpr float SS_SCALE = 1048576.0f, SS_INV = 1.0f / 1048576.0f;

struct EpiQKV {
    static constexpr bool PERM = true, AFTER_DRAIN = false;
    bf16_t* O; const unsigned long long* ss; const float* rope; float* wi32;
    __device__ __forceinline__ static float x16(float v, bool odd) {
        const unsigned uu = __float_as_uint(v); auto rr = __builtin_amdgcn_permlane16_swap(uu, uu, false, false); return __uint_as_float(odd ? rr[0] : rr[1]); }
    __device__ __forceinline__ void operator()(const f32x4 (&acc)[2][2][4][2], const Unit& u, int wr, int wc, int fr, int fq) const {
        const int row0 = u.pm * BM + wr * 64 + fr; const int cb0 = u.pn * BM + wc * 32;
        unsigned long long sv[8];
#pragma unroll
        for (int i = 0; i < 8; ++i) sv[i] = ss[row0 + (i >> 2) * HALF + (i & 3) * 16];
        const bool rp0 = ((cb0 < 2304) || (cb0 >= 2560 && cb0 < 3648)) && ((cb0 & 32) == 0);
        const bool rp1 = ((cb0 + HALF < 2304) || (cb0 + HALF >= 2560 && cb0 + HALF < 3648)) && ((cb0 & 32) == 0);
        const bool anyrp = rp0 || rp1;
        f32x4 nr[4] = {};
        if (anyrp) { const float* rq = rope + (size_t)row0 * 16; nr[0] = *(const f32x4*)rq; nr[1] = *(const f32x4*)(rq + 4); nr[2] = *(const f32x4*)(rq + 8); nr[3] = *(const f32x4*)(rq + 12); }
#pragma unroll
        for (int it = 0; it < 8; ++it) {
            const int ai = it >> 2, m = it & 3;
            const int row = row0 + ai * HALF + m * 16;
            const float rs = 1.0f / sqrtf((float)sv[it] * (SS_INV / XD) + RMS_EPS);
            const f32x4 c0 = nr[0], c1 = nr[1], s0 = nr[2], s1 = nr[3];
            if (anyrp && it < 7) { const float* rq = rope + (size_t)(row0 + ((it + 1) >> 2) * HALF + ((it + 1) & 3) * 16) * 16;
                nr[0] = *(const f32x4*)rq; nr[1] = *(const f32x4*)(rq + 4); nr[2] = *(const f32x4*)(rq + 8); nr[3] = *(const f32x4*)(rq + 12); }
#pragma unroll
            for (int bj = 0; bj < 2; ++bj) {
                const int cb = cb0 + bj * HALF;
                f32x4 v0 = acc[ai][bj][m][0] * rs, v1 = acc[ai][bj][m][1] * rs;
                if (bj ? rp1 : rp0) {
                    f32x4 p0, p1;
#pragma unroll
                    for (int e = 0; e < 4; ++e) { p0[e] = x16(v0[e], fq & 1); p1[e] = x16(v1[e], fq & 1); }
                    if (fq == 0) { v0 = v0 * c0 - p0 * s0; v1 = v1 * c1 - p1 * s1; }
                    else if (fq == 1) { v0 = v0 * c0 + p0 * s0; v1 = v1 * c1 + p1 * s1; }
                }
                u32x4 w; w.x = cvt_pk_bf16(v0[0], v0[1]); w.y = cvt_pk_bf16(v0[2], v0[3]); w.z = cvt_pk_bf16(v1[0], v1[1]); w.w = cvt_pk_bf16(v1[2], v1[3]);
                *(u32x4*)(O + (size_t)row * LDQ + cb + 8 * fq) = w;
                if (cb == 3648 && fq < 2) { float* wp = wi32 + (size_t)row * 16 + 8 * fq; *(f32x4*)wp = v0; *(f32x4*)(wp + 4) = v1; }
            }
            asm volatile("" ::: "memory");
        }
    }
};
struct EpiRes {
    static constexpr bool PERM = true, AFTER_DRAIN = false;
    const float* base; float* out; bf16_t* xb; unsigned long long* ssn;
    __device__ __forceinline__ void operator()(const f32x4 (&acc)[2][2][4][2], const Unit& u, int wr, int wc, int fr, int fq) const {
        const int row0 = u.pm * BM + wr * 64 + fr; const int col0 = u.pn * BM + wc * 32 + 8 * fq;
        f32x4 nb[4];
        { const size_t off = (size_t)row0 * XD + col0; nb[0] = *(const f32x4*)(base + off); nb[1] = *(const f32x4*)(base + off + 4); nb[2] = *(const f32x4*)(base + off + HALF); nb[3] = *(const f32x4*)(base + off + HALF + 4); }
#pragma unroll
        for (int it = 0; it < 8; ++it) {
            const int ai = it >> 2, m = it & 3;
            const int row = row0 + ai * HALF + m * 16; float sq = 0.f;
            const f32x4 cb0 = nb[0], cb1 = nb[1], cb2 = nb[2], cb3 = nb[3];
            if (it < 7) { const size_t offn = (size_t)(row0 + ((it + 1) >> 2) * HALF + ((it + 1) & 3) * 16) * XD + col0;
                nb[0] = *(const f32x4*)(base + offn); nb[1] = *(const f32x4*)(base + offn + 4); nb[2] = *(const f32x4*)(base + offn + HALF); nb[3] = *(const f32x4*)(base + offn + HALF + 4); }
#pragma unroll
            for (int bj = 0; bj < 2; ++bj) {
                const size_t off = (size_t)row * XD + col0 + bj * HALF;
                const f32x4 v0 = acc[ai][bj][m][0] + (bj ? cb2 : cb0), v1 = acc[ai][bj][m][1] + (bj ? cb3 : cb1);
                if (out) { __builtin_nontemporal_store(v0, (f32x4*)(out + off)); __builtin_nontemporal_store(v1, (f32x4*)(out + off + 4)); }
                u32x4 w; w.x = cvt_pk_bf16(v0[0], v0[1]); w.y = cvt_pk_bf16(v0[2], v0[3]); w.z = cvt_pk_bf16(v1[0], v1[1]); w.w = cvt_pk_bf16(v1[2], v1[3]);
                if (xb) *(u32x4*)(xb + off) = w;
                sq += (v0[0] * v0[0] + v0[1] * v0[1]) + (v0[2] * v0[2] + v0[3] * v0[3]) + (v1[0] * v1[0] + v1[1] * v1[1]) + (v1[2] * v1[2] + v1[3] * v1[3]);
            }
            { const unsigned u1 = __float_as_uint(sq); auto r1 = __builtin_amdgcn_permlane16_swap(u1, u1, false, false); sq = __uint_as_float(r1[0]) + __uint_as_float(r1[1]);
              const unsigned u2 = __float_as_uint(sq); auto r2 = __builtin_amdgcn_permlane32_swap(u2, u2, false, false); sq = __uint_as_float(r2[0]) + __uint_as_float(r2[1]); }
            if (fq == 0) atomicAdd(ssn + row, (unsigned long long)(sq * SS_SCALE));
            asm volatile("" ::: "memory");
        }
    }
};
struct EpiUp {
    static constexpr bool PERM = true, AFTER_DRAIN = false;
    bf16_t* O; const unsigned long long* ss; int ldc;
    __device__ __forceinline__ void operator()(const f32x4 (&acc)[2][2][4][2], const Unit& u, int wr, int wc, int fr, int fq) const {
        const int row0 = u.pm * BM + wr * 64 + fr; const int col0 = u.pn * BM + wc * 32 + 8 * fq;
        unsigned long long sv[8];
#pragma unroll
        for (int i = 0; i < 8; ++i) sv[i] = ss[row0 + (i >> 2) * HALF + (i & 3) * 16];
#pragma unroll
        for (int ai = 0; ai < 2; ++ai)
#pragma unroll
            for (int m = 0; m < 4; ++m) {
                const int row = row0 + ai * HALF + m * 16;
                const float rs = 1.0f / sqrtf((float)sv[ai * 4 + m] * (SS_INV / XD) + RMS_EPS);
#pragma unroll
                for (int bj = 0; bj < 2; ++bj) {
                    f32x4 v0 = acc[ai][bj][m][0] * rs, v1 = acc[ai][bj][m][1] * rs;
#pragma unroll
                    for (int e = 0; e < 4; ++e) { const float a = fmaxf(v0[e], 0.f), b = fmaxf(v1[e], 0.f); v0[e] = a * a; v1[e] = b * b; }
                    u32x4 w; w.x = cvt_pk_bf16(v0[0], v0[1]); w.y = cvt_pk_bf16(v0[2], v0[3]); w.z = cvt_pk_bf16(v1[0], v1[1]); w.w = cvt_pk_bf16(v1[2], v1[3]);
                    __builtin_nontemporal_store(w, (u32x4*)(O + (size_t)row * ldc + col0 + bj * HALF));
                }
            }
    }
};

template <class Epi, class Sched, bool ALIGN_EPI = false, bool SP2 = false>
__device__ __forceinline__ void gemm_phase(PG8_LAS unsigned char* lds, const Gemm g, const Sched& S, const Epi& E) {
    int tid_ = threadIdx.x; asm volatile("" : "+v"(tid_));
    const int tid = tid_, wid = __builtin_amdgcn_readfirstlane(tid >> 6), lane = tid & 63, wr = wid >> 2, wc = wid & 3, fr = lane & 15, fq = lane >> 4;
    const int K = g.K, nt = K / BK;
    unsigned voffA[2], voffB[2];
#pragma unroll
    for (int i = 0; i < 2; ++i) { int R, C; stage_rc(tid * 16 + i * 8192, R, C); const int Rb = Epi::PERM ? ((R & ~31) + perm32(R & 31)) : R;
        voffA[i] = (unsigned)(R * K + C) * 2u; voffB[i] = (unsigned)(Rb * K + C) * 2u; }
    const size_t kstep = (size_t)(BK * 2);
    const size_t hstep = (size_t)HALF * K * 2;
    const size_t tstep = 2 * hstep;
    const unsigned ldsw = (unsigned)wid * 1024u;
    const int aoff = lds_byte(wr * 64 + fr, fq * 8), boff = lds_byte(wc * 32 + fr, fq * 8);
#define PG8_SA(b, h) (((b) * 2 + (h)) * HTB)
#define PG8_SB(b, h) ((4 + (b) * 2 + (h)) * HTB)
#define PG8_STAGE(bufoff, gbase, voff) do { _Pragma("unroll") for (int _i = 0; _i < 2; ++_i) \
        __builtin_amdgcn_global_load_lds((const unsigned*)((const char*)(gbase) + (voff)[_i]), (PG8_LAS unsigned*)(lds + (bufoff) + ldsw + _i * 8192), 16, 0, 0); } while (0)
#define PG8_LDA(dst, b, h) do { _Pragma("unroll") for (int m = 0; m < 4; ++m) _Pragma("unroll") for (int k = 0; k < 2; ++k) dst[m][k] = *(const PG8_LAS bf16x8*)(lds + PG8_SA(b, h) + aoff + m * 2048 + k * 1024); } while (0)
#define PG8_LDB(dst, b, h) do { _Pragma("unroll") for (int n = 0; n < 2; ++n) _Pragma("unroll") for (int k = 0; k < 2; ++k) dst[n][k] = *(const PG8_LAS bf16x8*)(lds + PG8_SB(b, h) + boff + n * 2048 + k * 1024); } while (0)
#define PG8_MMA(ai, bj, At, Bt) do { __builtin_amdgcn_s_setprio(1); _Pragma("unroll") for (int m = 0; m < 4; ++m) _Pragma("unroll") for (int n = 0; n < 2; ++n) _Pragma("unroll") for (int k = 0; k < 2; ++k) \
        acc[ai][bj][m][n] = __builtin_amdgcn_mfma_f32_16x16x32_bf16(Bt[n][k], At[m][k], acc[ai][bj][m][n], 0, 0, 0); __builtin_amdgcn_s_setprio(0); } while (0)
#define PG8_WAIT_V(n) asm volatile("s_waitcnt vmcnt(" #n ")" ::: "memory")
#define PG8_WAIT_L(n) asm volatile("s_waitcnt lgkmcnt(" #n ")" ::: "memory")
#define PG8_BAR __builtin_amdgcn_s_barrier()
#define PG8_SCHED __builtin_amdgcn_sched_barrier(0)
    Unit cur, nxt; int ui = 0;
    if (!S.next(0, cur)) return;
    f32x4 acc[2][2][4][2];
#pragma unroll
    for (int a = 0; a < 2; ++a)
#pragma unroll
        for (int b = 0; b < 2; ++b)
#pragma unroll
            for (int m = 0; m < 4; ++m)
#pragma unroll
                for (int n = 0; n < 2; ++n) acc[a][b][m][n] = (f32x4){0.f, 0.f, 0.f, 0.f};
    bf16x8 At[4][2], B0[2][2], B1[2][2];
    const char* cA = (const char*)g.A + (size_t)cur.pm * tstep; const char* cB = (const char*)g.Bt + (size_t)cur.pn * tstep;
    S.a_ready(cur);
    if constexpr (SP2) {
        PG8_STAGE(PG8_SB(0, 0), cB, voffB); PG8_STAGE(PG8_SB(0, 1), cB + hstep, voffB); PG8_STAGE(PG8_SA(0, 0), cA, voffA); PG8_STAGE(PG8_SA(0, 1), cA + hstep, voffA);
        if (wr == 1) PG8_BAR;
        PG8_WAIT_V(2); PG8_BAR;
        PG8_STAGE(PG8_SB(1, 0), cB + kstep, voffB); PG8_STAGE(PG8_SA(1, 0), cA + kstep, voffA); PG8_STAGE(PG8_SB(1, 1), cB + hstep + kstep, voffB);
        PG8_WAIT_V(6); PG8_BAR;
    } else {
        PG8_STAGE(PG8_SB(0, 0), cB, voffB); PG8_STAGE(PG8_SA(0, 0), cA, voffA); PG8_STAGE(PG8_SB(0, 1), cB + hstep, voffB); PG8_STAGE(PG8_SA(0, 1), cA + hstep, voffA);
        if (wr == 1) PG8_BAR;
        PG8_WAIT_V(4); PG8_BAR;
        PG8_STAGE(PG8_SB(1, 0), cB + kstep, voffB); PG8_STAGE(PG8_SA(1, 0), cA + kstep, voffA); PG8_STAGE(PG8_SB(1, 1), cB + hstep + kstep, voffB);
        PG8_WAIT_V(6); PG8_BAR;
    }
    for (;;) {
        const bool has_next = S.next(ui + 1, nxt);
        const char* nA = has_next ? (const char*)g.A + (size_t)nxt.pm * tstep : cA; const char* nB = has_next ? (const char*)g.Bt + (size_t)nxt.pn * tstep : cB;
        for (int t = 0; t < nt; t += 2) {
            const bool last = (t == nt - 2);
            const char* a1 = cA + (size_t)(t + 1) * kstep;
            const char* a2 = last ? nA : cA + (size_t)(t + 2) * kstep; const char* b2 = last ? nB : cB + (size_t)(t + 2) * kstep;
            const char* a3 = a2 + kstep; const char* b3 = b2 + kstep;
            if (last && has_next) S.a_ready(nxt);
            if constexpr (SP2) {
            PG8_LDB(B0, 0, 0); PG8_LDB(B1, 0, 1); PG8_SCHED; PG8_LDA(At, 0, 0); PG8_STAGE(PG8_SA(1, 1), a1 + hstep, voffA);
            PG8_WAIT_V(8); PG8_WAIT_L(0); PG8_BAR; PG8_MMA(0, 0, At, B0); PG8_MMA(0, 1, At, B1); PG8_BAR; PG8_SCHED;
            PG8_LDA(At, 0, 1); PG8_STAGE(PG8_SB(0, 0), b2, voffB); PG8_STAGE(PG8_SB(0, 1), b2 + hstep, voffB); PG8_STAGE(PG8_SA(0, 0), a2, voffA);
            PG8_WAIT_V(8); PG8_WAIT_L(0); PG8_BAR; PG8_MMA(1, 0, At, B0); PG8_MMA(1, 1, At, B1); PG8_BAR; PG8_SCHED;
            PG8_LDB(B0, 1, 0); PG8_LDB(B1, 1, 1); PG8_SCHED; PG8_LDA(At, 1, 0); PG8_STAGE(PG8_SA(0, 1), a2 + hstep, voffA);
            PG8_WAIT_V(8); PG8_WAIT_L(0); PG8_BAR; PG8_MMA(0, 0, At, B0); PG8_MMA(0, 1, At, B1); PG8_BAR; PG8_SCHED;
            PG8_LDA(At, 1, 1); PG8_STAGE(PG8_SB(1, 0), b3, voffB); PG8_STAGE(PG8_SB(1, 1), b3 + hstep, voffB); PG8_STAGE(PG8_SA(1, 0), a3, voffA);
            PG8_WAIT_V(8); PG8_WAIT_L(0); PG8_BAR; PG8_MMA(1, 0, At, B0); PG8_MMA(1, 1, At, B1); PG8_BAR; PG8_SCHED;
            } else {
            PG8_LDB(B0, 0, 0); PG8_SCHED; PG8_LDA(At, 0, 0); PG8_STAGE(PG8_SA(1, 1), a1 + hstep, voffA);
            PG8_WAIT_L(8); PG8_BAR; PG8_WAIT_L(0); PG8_MMA(0, 0, At, B0); PG8_BAR; PG8_SCHED;
            PG8_LDB(B1, 0, 1); PG8_STAGE(PG8_SB(0, 0), b2, voffB);
            PG8_BAR; PG8_WAIT_L(0); PG8_MMA(0, 1, At, B1); PG8_BAR;
            PG8_LDA(At, 0, 1); PG8_STAGE(PG8_SA(0, 0), a2, voffA);
            PG8_BAR; PG8_WAIT_L(0); PG8_MMA(1, 0, At, B0); PG8_BAR; PG8_SCHED;
            PG8_STAGE(PG8_SB(0, 1), b2 + hstep, voffB);
            PG8_WAIT_V(6); PG8_BAR; PG8_MMA(1, 1, At, B1); PG8_BAR;
            PG8_LDB(B0, 1, 0); PG8_SCHED; PG8_LDA(At, 1, 0); PG8_STAGE(PG8_SA(0, 1), a2 + hstep, voffA);
            PG8_WAIT_L(8); PG8_BAR; PG8_WAIT_L(0); PG8_MMA(0, 0, At, B0); PG8_BAR; PG8_SCHED;
            PG8_LDB(B1, 1, 1); PG8_STAGE(PG8_SB(1, 0), b3, voffB);
            PG8_BAR; PG8_WAIT_L(0); PG8_MMA(0, 1, At, B1); PG8_BAR;
            PG8_LDA(At, 1, 1); PG8_STAGE(PG8_SA(1, 0), a3, voffA);
            PG8_BAR; PG8_WAIT_L(0); PG8_MMA(1, 0, At, B0); PG8_BAR; PG8_SCHED;
            PG8_STAGE(PG8_SB(1, 1), b3 + hstep, voffB);
            PG8_WAIT_V(6); PG8_BAR; PG8_MMA(1, 1, At, B1); PG8_BAR;
            }
        }
        if constexpr (ALIGN_EPI) { if (wr == 0) PG8_BAR; }
        if constexpr (!Epi::AFTER_DRAIN) { E(acc, cur, wr, wc, fr, fq); S.done(cur); }
        if (!has_next) break;
#pragma unroll
        for (int a = 0; a < 2; ++a)
#pragma unroll
            for (int b = 0; b < 2; ++b)
#pragma unroll
                for (int m = 0; m < 4; ++m)
#pragma unroll
                    for (int n = 0; n < 2; ++n) acc[a][b][m][n] = (f32x4){0.f, 0.f, 0.f, 0.f};
        cur = nxt; cA = nA; cB = nB; ++ui;
        if constexpr (ALIGN_EPI) { if (wr == 1) PG8_BAR; }
    }
    PG8_WAIT_V(0);
    if constexpr (!ALIGN_EPI) { if (wr == 0) PG8_BAR; }
    PG8_BAR;
    if constexpr (Epi::AFTER_DRAIN) { E.fused(acc, cur, wr, wc, fr, fq, lds, wid, lane); S.done(cur); }
#undef PG8_SA
#undef PG8_SB
#undef PG8_STAGE
#undef PG8_LDA
#undef PG8_LDB
#undef PG8_MMA
#undef PG8_WAIT_V
#undef PG8_WAIT_L
#undef PG8_BAR
#undef PG8_SCHED
}
}

namespace mk {
using pg8::bf16_t; using pg8::bf16x8; using pg8::f32x4; using pg8::u32x4; using pg8::LDQ; using pg8::RMS_EPS; using pg8::SS_SCALE; using pg8::SS_INV;
typedef float f32x16 __attribute__((ext_vector_type(16)));
typedef short s16x4 __attribute__((ext_vector_type(4)));
typedef short v4i16_t __attribute__((ext_vector_type(4)));
typedef unsigned u32x2 __attribute__((ext_vector_type(2)));
#define LAS __attribute__((address_space(3)))

constexpr int NB = 2, T = 8192, M = NB * T, D = 2048, FF = 8192, NLAYER = 4;
constexpr int QOFF = 0, KOFF = 2048, VOFF = 2304, QIOFF = 2560, KIOFF = 3584;
constexpr int SW = 8196;
constexpr float LOG2E = 1.4426950408889634f, C2 = 0.125f * LOG2E;
constexpr size_t MiB = 1u << 20;
constexpr size_t WS_SS = 0, WS_BAR = 1536 * 1024, WS_ROPE = 2 * MiB, WS_WI = 3 * MiB, WS_WIN = 4 * MiB, WS_WOUT = 49 * MiB, WS_WUP = 81 * MiB, WS_WDN = 209 * MiB;
constexpr size_t WS_XB = 340 * MiB, WS_QKV = 404 * MiB, WS_ATT = 524 * MiB, WS_H = 588 * MiB, WS_END = 848 * MiB;
constexpr int LDS_BYTES = 147968, WAVE_LDS = 18432;
constexpr int NPHASE = 1 + NLAYER * 5 + 1 + 1;

__host__ __device__ __forceinline__ size_t win_off(int l) { return WS_WIN + (size_t)(l == 0 ? 0 : l == 1 ? 10 : l == 2 ? 25 : 35) * MiB; }
__device__ __forceinline__ int crow(int r, int hi) { return (r & 3) + 8 * (r >> 2) + 4 * hi; }
__device__ __forceinline__ float wave_sum(float v) {
#pragma unroll
    for (int o = 1; o < 64; o <<= 1) v += __shfl_xor(v, o);
    return v;
}
__device__ __forceinline__ unsigned f2bf(float f) { unsigned u = __builtin_bit_cast(unsigned, f); return (u + 0x7fffu + ((u >> 16) & 1u)) >> 16; }
__device__ __forceinline__ unsigned pk2(float lo, float hi) { return f2bf(lo) | (f2bf(hi) << 16); }
__device__ __forceinline__ float ex2(float x) { return __builtin_amdgcn_exp2f(x); }
__device__ __forceinline__ float xhalf(float v, int hi) {
    const unsigned u = __float_as_uint(v); auto rr = __builtin_amdgcn_permlane32_swap(u, u, false, false); return __uint_as_float(hi ? rr[0] : rr[1]); }
__device__ __forceinline__ float vmax(float a, float b) { float r; asm("v_max_f32_e32 %0, %1, %2" : "=v"(r) : "v"(a), "v"(b)); return r; }
__device__ __forceinline__ float vmax3(float a, float b, float c) { float r; asm("v_max3_f32 %0, %1, %2, %3" : "=v"(r) : "v"(a), "v"(b), "v"(c)); return r; }
__device__ __forceinline__ float vrelu(float a) { return __builtin_bit_cast(float, max(__builtin_bit_cast(int, a), 0)); }
__device__ __forceinline__ s16x4 vtr(const LAS unsigned char* p) { return __builtin_bit_cast(s16x4, __builtin_amdgcn_ds_read_tr16_b64_v4i16((LAS v4i16_t*)p)); }

struct Args { const float* in[14]; float* out; unsigned char* ws; int ph_lo, ph_hi; };

__device__ __forceinline__ void tr_item(const float* W, const float* gain, int K, int N, int Npad, bf16_t* WT, int item, int lane) {
    const int nblk = Npad / 64, kb = item / nblk, nb = item % nblk, k0 = 64 * kb, n0 = 64 * nb;
    const int kr = lane >> 4, nc = lane & 15, n = n0 + 4 * nc; const bool ok = n < N;
    const float* src = W + (size_t)(k0 + 16 * kr) * N + n;
    f32x4 v[16];
#pragma unroll
    for (int i = 0; i < 16; ++i) v[i] = ok ? __builtin_nontemporal_load((const f32x4*)(src + (size_t)i * N)) : (f32x4){0.f, 0.f, 0.f, 0.f};
    if (gain) {
        const f32x4* gp = (const f32x4*)(gain + k0 + 16 * kr);
#pragma unroll
        for (int q = 0; q < 4; ++q) { const f32x4 gq = gp[q]; v[4 * q] *= gq.x; v[4 * q + 1] *= gq.y; v[4 * q + 2] *= gq.z; v[4 * q + 3] *= gq.w; }
    }
#pragma unroll
    for (int e = 0; e < 4; ++e) {
        u32x4 o0, o1;
        o0.x = pg8::cvt_pk_bf16(v[0][e], v[1][e]); o0.y = pg8::cvt_pk_bf16(v[2][e], v[3][e]); o0.z = pg8::cvt_pk_bf16(v[4][e], v[5][e]); o0.w = pg8::cvt_pk_bf16(v[6][e], v[7][e]);
        o1.x = pg8::cvt_pk_bf16(v[8][e], v[9][e]); o1.y = pg8::cvt_pk_bf16(v[10][e], v[11][e]); o1.z = pg8::cvt_pk_bf16(v[12][e], v[13][e]); o1.w = pg8::cvt_pk_bf16(v[14][e], v[15][e]);
        bf16_t* dst = WT + (size_t)(n + e) * K + k0 + 16 * kr;
        __builtin_nontemporal_store(o0, (u32x4*)dst); __builtin_nontemporal_store(o1, (u32x4*)(dst + 8));
    }
}
__device__ __forceinline__ void sincos_red(float angf, float& sn, float& cs) {
    const double TWO_PI = 6.283185307179586476925286766559;
    const double a = (double)angf; const double k = rint(a * (1.0 / TWO_PI)); const double r = fma(-k, TWO_PI, a); const double r2 = r * r;
    double s = 1.0, c = 1.0;
#pragma unroll
    for (int n = 14; n >= 1; --n) { s = 1.0 - s * r2 / (double)((2 * n) * (2 * n + 1)); c = 1.0 - c * r2 / (double)((2 * n - 1) * (2 * n)); }
    sn = (float)(s * r); cs = (float)c;
}
__device__ __forceinline__ void prologue(const Args& a, LAS unsigned char* lds, int gw, int NGW, int wave, int lane) {
    unsigned char* ws = a.ws;
    for (int mi = 0; mi < 16; ++mi) {
        const int l = mi >> 2, which = mi & 3, kind = l % 3, j = l / 3;
        const float* src; const float* gain = nullptr; int K, N, Np; bf16_t* dst;
        if (which == 0) { K = D; N = (kind == 1) ? 3664 : 2560; Np = (kind == 1) ? 3840 : 2560;
            src = (kind == 0 ? a.in[7] : kind == 1 ? a.in[10] : a.in[12]) + (size_t)j * D * N; gain = a.in[2] + l * D; dst = (bf16_t*)(ws + win_off(l)); }
        else if (which == 1) { K = D; N = D; Np = D; src = (kind == 0 ? a.in[9] : kind == 1 ? a.in[11] : a.in[13]) + (size_t)j * D * D; dst = (bf16_t*)(ws + WS_WOUT + (size_t)l * 8 * MiB); }
        else if (which == 2) { K = D; N = FF; Np = FF; src = a.in[4] + (size_t)l * D * FF; gain = a.in[3] + l * D; dst = (bf16_t*)(ws + WS_WUP + (size_t)l * 32 * MiB); }
        else { K = FF; N = D; Np = D; src = a.in[5] + (size_t)l * FF * D; dst = (bf16_t*)(ws + WS_WDN + (size_t)l * 32 * MiB); }
        if (which == 3 || (which == 2 && kind != 1)) continue;
        const int nitems = (K / 64) * (Np / 64);
        for (int it = gw; it < nitems; it += NGW) tr_item(src, gain, K, N, Np, dst, it, lane);
    }
    const float* x = a.in[0]; bf16_t* xb = (bf16_t*)(ws + WS_XB); unsigned long long* ss = (unsigned long long*)(ws + WS_SS);
    for (int row = gw; row < M; row += NGW) {
        const f32x4* xr = (const f32x4*)(x + (size_t)row * D) + lane; u32x2* o8 = (u32x2*)(xb + (size_t)row * D) + lane; float s = 0.f;
#pragma unroll
        for (int jj = 0; jj < 8; ++jj) { const f32x4 v = xr[64 * jj]; s += (v.x * v.x + v.y * v.y) + (v.z * v.z + v.w * v.w); u32x2 w; w.x = pk2(v.x, v.y); w.y = pk2(v.z, v.w); o8[64 * jj] = w; }
        s = wave_sum(s);
        if (lane == 0) ss[row] = (unsigned long long)(s * SS_SCALE);
        if (lane >= 1 && lane <= 8) ss[(size_t)lane * M + row] = 0ull;
    }
    const int* pos = (const int*)a.in[1]; float* rope = (float*)(ws + WS_ROPE);
    const float invf[8] = {1.0f, 0.1939227432012558f, 0.03760603070259094f, 0.007292664609849453f, 0.0014142135623842478f, 0.00027424818836152554f, 5.3182957344688475e-05f, 1.0313385246263351e-05f};
    for (int e = gw * 64 + lane; e < M * 8; e += NGW * 64) {
        const int row = e >> 3, i = e & 7;
        float inv = invf[0];
#pragma unroll
        for (int q = 1; q < 8; ++q) inv = (i == q) ? invf[q] : inv;
        const float ang = (float)pos[row] * inv; float sn, cs; sincos_red(ang, sn, cs);
        rope[(size_t)row * 16 + i] = cs; rope[(size_t)row * 16 + 8 + i] = sn;
    }
}

template <bool HALF>
__device__ __forceinline__ void attn_tile(const LAS unsigned char* Kt, const LAS unsigned char* Vt, int vplane, bf16x8 (&qr)[4], int dbase, int kstride, unsigned lim,
                                          f32x16& o0, f32x16& o1, float& m, float& l, int r32, int hi, int vb, const bf16_t* qnext = nullptr, bool half_rt = false) {
    const float NINF = -__builtin_inff();
    f32x16 p0 = {}, p1 = {};
    __builtin_amdgcn_s_setprio(1);
#pragma unroll
    for (int ks = 0; ks < 4; ++ks) {
        const int ko_ = r32 * 128 + (((2 * ks + hi) ^ ((r32 >> 1) & 7)) * 16);
        const bf16x8 a0 = *(const LAS bf16x8*)(Kt + ko_);
        p0 = __builtin_amdgcn_mfma_f32_32x32x16_bf16(a0, qr[ks], p0, 0, 0, 0);
        if (!HALF && !half_rt) { const bf16x8 a1 = *(const LAS bf16x8*)(Kt + ko_ + 4096); p1 = __builtin_amdgcn_mfma_f32_32x32x16_bf16(a1, qr[ks], p1, 0, 0, 0); }
    }
    __builtin_amdgcn_s_setprio(0);
    if (qnext) {
#pragma unroll
        for (int ks = 0; ks < 4; ++ks) qr[ks] = *(const bf16x8*)(qnext + 16 * ks);
    }
    if (!HALF && half_rt) {
#pragma unroll
        for (int r = 0; r < 16; ++r) p1[r] = NINF;
    }
    { const int dtop = dbase + 4 * hi * kstride, dlow = dtop - ((HALF || half_rt) ? 31 : 63) * kstride;
      if (!__all(dlow >= 0 && (unsigned)dtop <= lim)) {
#pragma unroll
        for (int r = 0; r < 16; ++r) {
            const int d0 = dbase - kstride * ((r & 3) + 8 * (r >> 2)), d1 = d0 - 32 * kstride;
            p0[r] = ((unsigned)d0 <= lim) ? p0[r] : NINF;
            if (!HALF) p1[r] = ((unsigned)d1 <= lim) ? p1[r] : NINF;
        }
      } }
    float mx = NINF;
#pragma unroll
    for (int r = 0; r < 16; ++r) {
        p0[r] *= C2;
        if (!HALF) { p1[r] *= C2; mx = __builtin_fmaxf(__builtin_fmaxf(mx, p0[r]), p1[r]); } else mx = __builtin_fmaxf(mx, p0[r]);
    }
    mx = __builtin_fmaxf(mx, xhalf(mx, hi));
    if (__any(mx > m + 6.0f)) {
        const float mn = __builtin_fmaxf(m, mx), mu2 = (mn == NINF) ? 0.f : mn, alpha = ex2(m - mu2);
        m = mn; l *= alpha;
#pragma unroll
        for (int r = 0; r < 16; ++r) { o0[r] *= alpha; o1[r] *= alpha; }
    }
    const float mu = (m == NINF) ? 0.f : m;
    float ls = 0.f;
    bf16x8 pa[4];
#pragma unroll
    for (int gq = 0; gq < ((HALF || half_rt) ? 2 : 4); ++gq) {
        float e[8];
#pragma unroll
        for (int i = 0; i < 8; ++i) { const float x = (gq < 2) ? p0[8 * (gq & 1) + i] : p1[8 * (gq & 1) + i]; e[i] = ex2(x - mu); ls += e[i]; }
        u32x4 w; w.x = pg8::cvt_pk_bf16(e[0], e[1]); w.y = pg8::cvt_pk_bf16(e[2], e[3]); w.z = pg8::cvt_pk_bf16(e[4], e[5]); w.w = pg8::cvt_pk_bf16(e[6], e[7]);
        pa[gq] = __builtin_bit_cast(bf16x8, w);
    }
    l += ls;
    __builtin_amdgcn_s_setprio(1);
#pragma unroll
    for (int kk = 0; kk < ((HALF || half_rt) ? 2 : 4); ++kk) {
        const s16x4 lo0 = vtr(Vt + vb + kk * 1024), hi0 = vtr(Vt + vb + kk * 1024 + 512);
        const s16x4 lo1 = vtr(Vt + vb + vplane + kk * 1024), hi1 = vtr(Vt + vb + vplane + kk * 1024 + 512);
        const bf16x8 v0 = (bf16x8){lo0[0], lo0[1], lo0[2], lo0[3], hi0[0], hi0[1], hi0[2], hi0[3]};
        const bf16x8 v1 = (bf16x8){lo1[0], lo1[1], lo1[2], lo1[3], hi1[0], hi1[1], hi1[2], hi1[3]};
        o0 = __builtin_amdgcn_mfma_f32_32x32x16_bf16(v0, pa[kk], o0, 0, 0, 0);
        o1 = __builtin_amdgcn_mfma_f32_32x32x16_bf16(v1, pa[kk], o1, 0, 0, 0);
    }
    __builtin_amdgcn_s_setprio(0);
}
template <bool GATHER, int KS>
__device__ __forceinline__ void attn_run(LAS unsigned char* wl, const bf16_t* Kg, const bf16_t* Vg, bf16x8 (&qr)[4], int ntiles, int kstart, int kstride_,
                                         int D0, unsigned lim, f32x16& o0, f32x16& o1, float& m, float& l, int lane, bool probe_noload = false, bool last_half = false) {
    const int r32 = lane & 31, hi = lane >> 5; const int kstride = KS ? KS : kstride_;
    LAS unsigned char* Kl = wl; LAS unsigned char* Vl = wl + 8192; const LAS int* idx = (const LAS int*)(wl + 16384);
    u32x4 kreg[8], vreg[8];
#define MK_POS(slot) (GATHER ? idx[(slot)] : min(max(kstart + kstride * (slot), 0), T - 1))
    const int srow_ = lane >> 3, sc_ = lane & 7;
#define MK_LOAD_TILE(t_) do { \
    _Pragma("unroll") for (int i_ = 0; i_ < 8; ++i_) { const int p_ = MK_POS(64 * (t_) + 8 * i_ + srow_); \
      const bf16_t* rp_ = Kg + (size_t)p_ * LDQ + sc_ * 8; kreg[i_] = *(const u32x4*)rp_; vreg[i_] = *(const u32x4*)(rp_ + (VOFF - KOFF)); } } while (0)
#define MK_STORE_TILE() do { \
    _Pragma("unroll") for (int i_ = 0; i_ < 8; ++i_) { const int key_ = 8 * i_ + srow_; \
      *(LAS u32x4*)(Kl + key_ * 128 + ((sc_ ^ ((key_ >> 1) & 7)) * 16)) = kreg[i_]; \
      *(LAS u32x4*)(Vl + (sc_ >> 2) * 4096 + key_ * 64 + (sc_ & 3) * 16) = vreg[i_]; } } while (0)
    MK_LOAD_TILE(0); asm volatile("" ::: "memory"); MK_STORE_TILE(); asm volatile("" ::: "memory");
    const int vb = ((lane >> 4) & 1) * 32 + (lane & 3) * 8 + (4 * hi + ((lane & 15) >> 2)) * 64;
    int dbase = D0 - kstride * 4 * hi;
    for (int t = 0; t < ntiles; ++t) {
        if (t + 1 < ntiles && !probe_noload) MK_LOAD_TILE(t + 1);
        attn_tile<false>(Kl, Vl, 4096, qr, dbase, kstride, lim, o0, o1, m, l, r32, hi, vb, nullptr, last_half && t + 1 == ntiles);
        dbase -= 64 * kstride;
        asm volatile("" ::: "memory");
        if (t + 1 < ntiles) MK_STORE_TILE();
        asm volatile("" ::: "memory");
    }
#undef MK_POS
#undef MK_LOAD_TILE
#undef MK_STORE_TILE
}
__device__ __forceinline__ void attn_store(bf16_t* orow, const f32x16& o0, const f32x16& o1, float inv, int hi) {
#pragma unroll
    for (int rg = 0; rg < 4; ++rg) {
        u32x2 w0, w1;
        w0.x = pg8::cvt_pk_bf16(o0[4 * rg] * inv, o0[4 * rg + 1] * inv); w0.y = pg8::cvt_pk_bf16(o0[4 * rg + 2] * inv, o0[4 * rg + 3] * inv);
        w1.x = pg8::cvt_pk_bf16(o1[4 * rg] * inv, o1[4 * rg + 1] * inv); w1.y = pg8::cvt_pk_bf16(o1[4 * rg + 2] * inv, o1[4 * rg + 3] * inv);
        *(u32x2*)(orow + 8 * rg + 4 * hi) = w0; *(u32x2*)(orow + 32 + 8 * rg + 4 * hi) = w1;
    }
}

__device__ __forceinline__ void swa_phase(const bf16_t* qkv, const float* sinks, bf16_t* att, LAS unsigned char* wl, int gw, int NGW, int lane, bool probe = false) {
    const int r32 = lane & 31, hi = lane >> 5, qi = r32 >> 3, g = r32 & 7;
    for (int u = gw; u < NB * 4 * (T / 4); u += NGW) {
        const int j = u % (T / 4), kvh = (u / (T / 4)) & 3, b = u / (T);
        const int t0 = 4 * j, tq = t0 + qi; const size_t rb = (size_t)b * T;
        bf16x8 qr[4];
        const bf16_t* qp = qkv + (rb + tq) * LDQ + QOFF + (kvh * 8 + g) * 64 + 8 * hi;
#pragma unroll
        for (int ks = 0; ks < 4; ++ks) qr[ks] = *(const bf16x8*)(qp + 16 * ks);
        const float sk = sinks[kvh * 8 + g] * LOG2E;
        f32x16 o0 = {}, o1 = {}; float m = sk, l = 0.f;
        const int kstart = t0 - 128;
        attn_run<false, 1>(wl, qkv + rb * LDQ + KOFF + kvh * 64, qkv + rb * LDQ + VOFF + kvh * 64, qr, 3, kstart, 1, tq - kstart, (unsigned)min(127, tq), o0, o1, m, l, lane, probe);
        l += __shfl_xor(l, 32); l += ex2(sk - m);
        if (!probe || l == 123.456f) attn_store(att + (rb + tq) * D + (kvh * 8 + g) * 64, o0, o1, 1.0f / l, hi);
    }
}
__device__ __forceinline__ void swa_phase_wg(const bf16_t* qkv, const float* sinks, bf16_t* att, LAS unsigned char* lds, int bid, int G, int tid, int wave, int lane) {
    constexpr int WROWS = 160, KIMG = WROWS * 128, VPL = WROWS * 64, BUF = KIMG + 2 * VPL, NBLK = T / 32, NU = NB * 4 * NBLK;
    const int r32 = lane & 31, hi = lane >> 5, qi = r32 >> 3, g = r32 & 7;
    const int vb = ((lane >> 4) & 1) * 32 + (lane & 3) * 8 + (4 * hi + ((lane & 15) >> 2)) * 64;
    u32x4 st[5];
#define SW_LOAD(u_) do { const int blk_ = (u_) % NBLK, kvh_ = ((u_) / NBLK) & 3, b_ = (u_) / (4 * NBLK); const int ws_ = 32 * blk_ - 128; const bf16_t* base_ = qkv + (size_t)b_ * T * LDQ + kvh_ * 64; \
    _Pragma("unroll") for (int i_ = 0; i_ < 5; ++i_) { const int id_ = tid + 512 * i_, row_ = id_ >> 4, c_ = id_ & 15; const int p_ = min(max(ws_ + row_, 0), T - 1); \
      st[i_] = *(const u32x4*)(base_ + (size_t)p_ * LDQ + (c_ < 8 ? KOFF + c_ * 8 : VOFF + (c_ - 8) * 8)); } } while (0)
#define SW_STORE(buf_) do { _Pragma("unroll") for (int i_ = 0; i_ < 5; ++i_) { const int id_ = tid + 512 * i_, row_ = id_ >> 4, c_ = id_ & 15; \
      if (c_ < 8) *(LAS u32x4*)((buf_) + row_ * 128 + ((c_ ^ ((row_ >> 1) & 7)) * 16)) = st[i_]; \
      else *(LAS u32x4*)((buf_) + KIMG + ((c_ - 8) >> 2) * VPL + row_ * 64 + ((c_ - 8) & 3) * 16) = st[i_]; } } while (0)
    int u = bid; if (u >= NU) return;
    SW_LOAD(u); SW_STORE(lds); __syncthreads();
    int pb = 0;
    for (; u < NU; u += G) {
        const int un = u + G; const bool has_next = un < NU;
        const int blk = u % NBLK, kvh = (u / NBLK) & 3, b = u / (4 * NBLK);
        const int t0 = 32 * blk, tq = t0 + 4 * wave + qi; const size_t rb = (size_t)b * T;
        bf16x8 qr[4];
        const bf16_t* qp = qkv + (rb + tq) * LDQ + QOFF + (kvh * 8 + g) * 64 + 8 * hi;
#pragma unroll
        for (int ks = 0; ks < 4; ++ks) qr[ks] = *(const bf16x8*)(qp + 16 * ks);
        if (has_next) SW_LOAD(un);
        const LAS unsigned char* buf = lds + pb * BUF;
        const float sk = sinks[kvh * 8 + g] * LOG2E;
        f32x16 o0 = {}, o1 = {}; float m = sk, l = 0.f;
        const unsigned lim = (unsigned)min(127, tq);
        int dbase = 128 + 4 * wave + qi - 4 * hi;
#pragma nounroll
        for (int tt = 0; tt < 2; ++tt) { attn_tile<false>(buf + 8192 * tt, buf + KIMG + 4096 * tt, VPL, qr, dbase, 1, lim, o0, o1, m, l, r32, hi, vb); dbase -= 64; asm volatile("" ::: "memory"); }
        attn_tile<true>(buf + 16384, buf + KIMG + 8192, VPL, qr, dbase, 1, lim, o0, o1, m, l, r32, hi, vb);
        l += __shfl_xor(l, 32); l += ex2(sk - m);
        attn_store(att + (rb + tq) * D + (kvh * 8 + g) * 64, o0, o1, 1.0f / l, hi);
        asm volatile("" ::: "memory");
        if (has_next) SW_STORE(lds + (pb ^ 1) * BUF);
        __syncthreads();
        pb ^= 1;
    }
#undef SW_LOAD
#undef SW_STORE
}
__device__ __forceinline__ void dil_phase(const bf16_t* qkv, bf16_t* att, LAS unsigned char* wl, int gw, int NGW, int lane) {
    const int r32 = lane & 31, hi = lane >> 5, qi = r32 >> 3, g = r32 & 7;
    for (int u = gw; u < NB * 4 * (T / 4); u += NGW) {
        const int res = u & 15, blk = (u >> 4) & 127, kvh = (u >> 11) & 3, b = u >> 13;
        const int t0 = 64 * blk + res, tq = t0 + 16 * qi; const size_t rb = (size_t)b * T;
        bf16x8 qr[4];
        const bf16_t* qp = qkv + (rb + tq) * LDQ + QOFF + (kvh * 8 + g) * 64 + 8 * hi;
#pragma unroll
        for (int ks = 0; ks < 4; ++ks) qr[ks] = *(const bf16x8*)(qp + 16 * ks);
        f32x16 o0 = {}, o1 = {}; float m = -__builtin_inff(), l = 0.f;
        const bf16_t* Kb = qkv + rb * LDQ + KOFF + kvh * 64; const bf16_t* Vb = qkv + rb * LDQ + VOFF + kvh * 64;
        attn_run<false, 1>(wl, Kb, Vb, qr, 3, t0 - 128, 1, tq - (t0 - 128), (unsigned)min(128, tq), o0, o1, m, l, lane);
        attn_run<false, 4>(wl, Kb, Vb, qr, 3, t0 - 512, 4, tq - (t0 - 512), (unsigned)min(512, tq), o0, o1, m, l, lane, false, true);
        attn_run<false, 16>(wl, Kb, Vb, qr, 3, t0 - 2048, 16, tq - (t0 - 2048), (unsigned)min(2048, tq), o0, o1, m, l, lane, false, true);
        l += __shfl_xor(l, 32);
        attn_store(att + (rb + tq) * D + (kvh * 8 + g) * 64, o0, o1, 1.0f / l, hi);
    }
}
__device__ __forceinline__ size_t score_off(int b, int t) { return b == 0 ? (size_t)t * SW : (size_t)(T - 1 - t) * SW + ((T - t + 3) & ~3); }
__device__ __forceinline__ void indexer_phase(const bf16_t* qkv, const float* wi32, float* scores, int gw, int NGW, int lane, bool do_store = true) {
    const int r32 = lane & 31, hi = lane >> 5;
    for (int u = gw; u < NB * (T / 4); u += NGW) {
        const int b = u / (T / 4), jj = u % (T / 4), j = (b == 0) ? jj : (T / 4 - 1 - jj);
        const int t0 = 4 * j; const size_t rb = (size_t)b * T;
        bf16x8 aq[2][4]; float wr[2][16];
#pragma unroll
        for (int s = 0; s < 2; ++s) {
            const bf16_t* qp = qkv + (rb + t0 + 2 * s + (r32 >> 4)) * LDQ + QIOFF + (r32 & 15) * 64 + 8 * hi;
#pragma unroll
            for (int ks = 0; ks < 4; ++ks) aq[s][ks] = *(const bf16x8*)(qp + 16 * ks);
#pragma unroll
            for (int r = 0; r < 16; ++r) { const int row = crow(r, hi); wr[s][r] = wi32[(rb + t0 + 2 * s + (row >> 4)) * 16 + (row & 15)] * 0.03125f; }
        }
        const int nsub = (t0 + 4 + 31) / 32;
        const bf16_t* kbase = qkv + rb * LDQ + KIOFF + 8 * hi + (size_t)r32 * LDQ;
        bf16x8 kq[2][4];
#define MK_KLOAD(slot, sub_) do { const bf16_t* kp_ = kbase + (size_t)(32 * (sub_)) * LDQ; \
        _Pragma("unroll") for (int ks = 0; ks < 4; ++ks) kq[slot][ks] = *(const bf16x8*)(kp_ + 16 * ks); } while (0)
#define MK_KSTEP(slot, sub_) do { if ((sub_) < nsub) { \
            const int key = 32 * (sub_) + r32; \
            f32x16 acc0 = {}, acc1 = {}; \
            _Pragma("unroll") for (int ks = 0; ks < 4; ++ks) acc0 = __builtin_amdgcn_mfma_f32_32x32x16_bf16(aq[0][ks], kq[slot][ks], acc0, 0, 0, 0); \
            _Pragma("unroll") for (int ks = 0; ks < 4; ++ks) acc1 = __builtin_amdgcn_mfma_f32_32x32x16_bf16(aq[1][ks], kq[slot][ks], acc1, 0, 0, 0); \
            if ((sub_) + 2 < nsub) MK_KLOAD(slot, (sub_) + 2); \
            MK_KRED(acc0, 0); MK_KRED(acc1, 1); } } while (0)
#define MK_KRED(acc, s) do { \
            float pa = 0.f, pb = 0.f; \
            _Pragma("unroll") for (int r = 0; r < 8; ++r) { pa = fmaf(vrelu(acc[r]), wr[s][r], pa); pb = fmaf(vrelu(acc[8 + r]), wr[s][8 + r], pb); } \
            const float mine = hi ? pb : pa, other = hi ? pa : pb; \
            const float tot = mine + __shfl_xor(other, 32); \
            const int tq = t0 + 2 * s + hi; \
            if (key <= tq && (do_store || tot == 123.456f)) scores[score_off(b, tq) + key] = tot; } while (0)
        MK_KLOAD(0, 0); if (1 < nsub) MK_KLOAD(1, 1);
        for (int sub = 0; sub < nsub; sub += 2) { MK_KSTEP(0, sub); MK_KSTEP(1, sub + 1); }
#undef MK_KLOAD
#undef MK_KSTEP
#undef MK_KRED
    }
}
__device__ __forceinline__ void indexer_phase_wg(const bf16_t* qkv, const float* wi32, float* scores, LAS unsigned char* lds, int bid, int G, int tid, int wave, int lane) {
    const int r32 = lane & 31, hi = lane >> 5;
    constexpr int NBLK = T / 32;
    const int srow = tid >> 3, sc = tid & 7;
    for (int u = bid; u < NB * NBLK; u += G) {
        const int b = u / NBLK, jj = u % NBLK, j = (b == 0) ? jj : (NBLK - 1 - jj);
        const int t0 = 32 * j + 4 * wave; const size_t rb = (size_t)b * T;
        bf16x8 aq[2][4]; float wr[2][16];
#pragma unroll
        for (int s = 0; s < 2; ++s) {
            const bf16_t* qp = qkv + (rb + t0 + 2 * s + (r32 >> 4)) * LDQ + QIOFF + (r32 & 15) * 64 + 8 * hi;
#pragma unroll
            for (int ks = 0; ks < 4; ++ks) aq[s][ks] = *(const bf16x8*)(qp + 16 * ks);
#pragma unroll
            for (int r = 0; r < 16; ++r) { const int row = crow(r, hi); wr[s][r] = wi32[(rb + t0 + 2 * s + (row >> 4)) * 16 + (row & 15)] * 0.03125f; }
        }
        const int nstep = (32 * j + 32 + 127) >> 7;
        const bf16_t* kg = qkv + (rb + srow) * LDQ + KIOFF + sc * 8;
        const int sdst = srow * 128 + ((sc ^ ((srow >> 1) & 7)) * 16);
        const int lastrow = 32 * j + 31;
        u32x4 kreg0 = *(const u32x4*)kg, kreg1 = *(const u32x4*)(kg + (size_t)min(64, lastrow - srow) * LDQ);
        __syncthreads();
        *(LAS u32x4*)(lds + sdst) = kreg0; *(LAS u32x4*)(lds + 8192 + sdst) = kreg1;
        __syncthreads();
        for (int st = 0; st < nstep; ++st) {
            if (st + 1 < nstep) { const int r0 = 128 * (st + 1);
                kreg0 = *(const u32x4*)(kg + (size_t)min(r0, lastrow - srow) * LDQ); kreg1 = *(const u32x4*)(kg + (size_t)min(r0 + 64, lastrow - srow) * LDQ); }
            const LAS unsigned char* buf = lds + (st & 1) * 16384;
#pragma unroll
            for (int sub = 0; sub < 4; ++sub) {
                const int k0 = 128 * st + 32 * sub;
                {
                    const int key = k0 + r32, lrow = 32 * (sub & 1) + r32;
                    const LAS unsigned char* img = buf + (sub >> 1) * 8192;
                    bf16x8 kf[4];
#pragma unroll
                    for (int ks = 0; ks < 4; ++ks) kf[ks] = *(const LAS bf16x8*)(img + lrow * 128 + (((2 * ks + hi) ^ ((lrow >> 1) & 7)) * 16));
                    f32x16 acc0 = {}, acc1 = {};
#pragma unroll
                    for (int ks = 0; ks < 4; ++ks) acc0 = __builtin_amdgcn_mfma_f32_32x32x16_bf16(aq[0][ks], kf[ks], acc0, 0, 0, 0);
#pragma unroll
                    for (int ks = 0; ks < 4; ++ks) acc1 = __builtin_amdgcn_mfma_f32_32x32x16_bf16(aq[1][ks], kf[ks], acc1, 0, 0, 0);
#define MK_KRED2(acc, s) do { \
                    float pa = 0.f, pb = 0.f; \
                    _Pragma("unroll") for (int r = 0; r < 8; ++r) { pa = fmaf(vrelu(acc[r]), wr[s][r], pa); pb = fmaf(vrelu(acc[8 + r]), wr[s][8 + r], pb); } \
                    const float mine = hi ? pb : pa, other = hi ? pa : pb; \
                    const float tot = mine + xhalf(other, hi); \
                    const int tq = t0 + 2 * s + hi; \
                    if (key <= tq) scores[score_off(b, tq) + key] = tot; } while (0)
                    MK_KRED2(acc0, 0); MK_KRED2(acc1, 1);
#undef MK_KRED2
                }
            }
            asm volatile("" ::: "memory");
            if (st + 1 < nstep) { LAS unsigned char* nb = lds + ((st + 1) & 1) * 16384; *(LAS u32x4*)(nb + sdst) = kreg0; *(LAS u32x4*)(nb + 8192 + sdst) = kreg1; }
            __syncthreads();
        }
    }
}
__device__ __forceinline__ unsigned f2key(float f) { const unsigned u = __float_as_uint(f); return (u & 0x80000000u) ? ~u : (u | 0x80000000u); }
__device__ __forceinline__ unsigned suffix_incl(unsigned v, int lane) {
#pragma unroll
    for (int off = 1; off < 64; off <<= 1) { const unsigned o = __shfl_down(v, off); if (lane + off < 64) v += o; }
    return v;
}
template <int NBIN> __device__ __forceinline__ void hist_zero(LAS unsigned* hist, int lane) {
    for (int i = lane * 4; i < NBIN; i += 256) *(LAS u32x4*)(hist + i) = (u32x4){0u, 0u, 0u, 0u};
}
template <int BITS> __device__ __forceinline__ unsigned find_bin(const LAS unsigned* hist, unsigned& k, int lane) {
    constexpr int NBIN = 1 << BITS, PER = NBIN / 64;
    unsigned s = 0;
#pragma unroll 8
    for (int j = 0; j < PER; ++j) s += hist[PER * lane + ((j + lane) & (PER - 1))];
    const unsigned incl = suffix_incl(s, lane), excl = incl - s;
    const bool hit = (excl < k) && (k <= incl);
    const int Ls = __ffsll((unsigned long long)__ballot(hit)) - 1;
    const unsigned exclS = __shfl(excl, Ls);
    const unsigned h = (lane < PER) ? hist[PER * Ls + (lane & (PER - 1))] : 0u;
    const unsigned incl2 = suffix_incl(h, lane) + exclS, excl2 = incl2 - h;
    const bool hit2 = (lane < PER) && (excl2 < k) && (k <= incl2);
    const int js = __ffsll((unsigned long long)__ballot(hit2)) - 1;
    k -= __shfl(excl2, js);
    return (unsigned)(PER * Ls + js);
}
#define MK_HADD(p) __hip_atomic_fetch_add((p), 1u, __ATOMIC_RELAXED, __HIP_MEMORY_SCOPE_WORKGROUP)
template <int BITS, int SHIFT, bool PREFIX>
__device__ __forceinline__ unsigned radix_pass(LAS unsigned* hist, const float* srow, int n, unsigned prefix, unsigned& k, int lane) {
    constexpr int NBIN = 1 << BITS;
    hist_zero<NBIN>(hist, lane);
    for (int i = lane; i < n; i += 64) {
        const unsigned key = f2key(srow[i]);
        bool in = true; if (PREFIX) in = (key >> ((SHIFT + BITS) & 31)) == prefix;
        if (in) MK_HADD(hist + ((key >> SHIFT) & (NBIN - 1)));
    }
    return find_bin<BITS>(hist, k, lane);
}
__device__ __forceinline__ void select256(LAS unsigned char* wl, const float* srow, int n, int lane) {
    constexpr int CAP = 1024;
    LAS unsigned* hist = (LAS unsigned*)wl; LAS int* idx = (LAS int*)(wl + 16384);
    LAS unsigned* candk = (LAS unsigned*)wl; LAS int* candi = (LAS int*)(wl + 4096); LAS unsigned* hist2 = (LAS unsigned*)(wl + 8192);
    const unsigned long long lt = (1ull << lane) - 1ull;
    unsigned k = 256;
    const f32x4* srow4 = (const f32x4*)srow;
#define SEL_LOAD4(v_, i0_) do { _Pragma("unroll") for (int q = 0; q < 16; ++q) { const int i_ = (i0_) + 256 * q + 4 * lane; v_[q] = (i_ < n) ? srow4[i_ >> 2] : (f32x4){0.f, 0.f, 0.f, 0.f}; } } while (0)
    hist_zero<4096>(hist, lane);
    for (int i0 = 0; i0 < n; i0 += 4096) {
        f32x4 v[16]; SEL_LOAD4(v, i0);
#pragma unroll
        for (int q = 0; q < 16; ++q)
#pragma unroll
            for (int e = 0; e < 4; ++e) { const int i = i0 + 256 * q + 4 * lane + e; if (i < n) MK_HADD(hist + (f2key(v[q][e]) >> 20)); }
    }
    const unsigned b1 = find_bin<12>(hist, k, lane);
    unsigned run = 0, cc = 0;
    for (int i0 = 0; i0 < n; i0 += 4096) {
        f32x4 v[16]; SEL_LOAD4(v, i0);
#pragma unroll
        for (int q = 0; q < 16; ++q)
#pragma unroll
            for (int e = 0; e < 4; ++e) {
                const int i = i0 + 256 * q + 4 * lane + e; const bool in = i < n; const unsigned key = f2key(v[q][e]); const unsigned bin = key >> 20;
                const bool gt = in && bin > b1, eq = in && bin == b1;
                const unsigned long long bg = __ballot(gt), be = __ballot(eq);
                if (gt) { const unsigned pos = run + (unsigned)__popcll(bg & lt); if (pos < 256u) idx[pos] = i; }
                if (eq) { const unsigned pos = cc + (unsigned)__popcll(be & lt); if (pos < (unsigned)CAP) { candk[pos] = key; candi[pos] = i; } }
                run += (unsigned)__popcll(bg); cc += (unsigned)__popcll(be);
            }
    }
#undef SEL_LOAD4
    if (cc <= (unsigned)CAP) {
        hist_zero<1024>(hist2, lane);
        for (unsigned c = lane; c < cc; c += 64) MK_HADD(hist2 + ((candk[c] >> 10) & 1023u));
        const unsigned b2 = find_bin<10>(hist2, k, lane);
        hist_zero<1024>(hist2, lane);
        for (unsigned c = lane; c < cc; c += 64) { const unsigned key = candk[c]; if (((key >> 10) & 1023u) == b2) MK_HADD(hist2 + (key & 1023u)); }
        const unsigned b3 = find_bin<10>(hist2, k, lane);
        const unsigned Tl = (b2 << 10) | b3, need = k; const unsigned E = hist2[b3];
        for (unsigned c0 = 0; c0 < cc; c0 += 64) {
            const unsigned c = c0 + lane; const bool in = c < cc; const unsigned low = in ? (candk[c] & 0xFFFFFu) : 0u;
            const bool gt = in && low > Tl, eq = in && low == Tl;
            bool take = gt || eq;
            if (E != need) {
                unsigned rank = 0; const int myi = in ? candi[c] : 0;
                for (unsigned c2 = 0; c2 < cc; ++c2) rank += ((candk[c2] & 0xFFFFFu) == Tl && candi[c2] < myi) ? 1u : 0u;
                take = gt || (eq && rank < need);
            }
            const unsigned long long bt = __ballot(take); const unsigned pos = run + (unsigned)__popcll(bt & lt);
            if (take && pos < 256u) idx[pos] = candi[c];
            run += (unsigned)__popcll(bt);
        }
    } else {
        unsigned k2 = 256;
        const unsigned c1 = radix_pass<12, 20, false>(hist, srow, n, 0u, k2, lane);
        const unsigned c2 = radix_pass<10, 10, true>(hist, srow, n, c1, k2, lane);
        const unsigned c3 = radix_pass<10, 0, true>(hist, srow, n, (c1 << 10) | c2, k2, lane);
        const unsigned Tk = (c1 << 20) | (c2 << 10) | c3, need = k2;
        unsigned r2 = 0, eqrun = 0;
        for (int i0 = 0; i0 < n; i0 += 64) {
            const int i = i0 + lane; const bool in = i < n; const unsigned key = in ? f2key(srow[i]) : 0u;
            const bool gt = in && key > Tk, eq = in && key == Tk;
            const unsigned long long beq = __ballot(eq); const unsigned eqr = eqrun + (unsigned)__popcll(beq & lt);
            const bool take = gt || (eq && eqr < need);
            const unsigned long long bt = __ballot(take); const unsigned pos = r2 + (unsigned)__popcll(bt & lt);
            if (take && pos < 256u) idx[pos] = i;
            r2 += (unsigned)__popcll(bt); eqrun += (unsigned)__popcll(beq);
        }
    }
}
__device__ __forceinline__ void dsa_select_phase(const float* scores, int* idxg, LAS unsigned char* wl, int gw, int NGW, int lane) {
    LAS int* idx = (LAS int*)(wl + 16384);
    for (int u = gw; u < M; u += NGW) {
        const int b = u / T, tt = u % T, t = ((tt >> 11) & 1) ? ((tt & ~2047) + 2047 - (tt & 2047)) : tt;
        const int n = t + 1;
        const float* srow = scores + score_off(b, t);
        if (n <= 256) { for (int i = lane; i < 256; i += 64) idx[i] = (i < n) ? i : 0; }
        else select256(wl, srow, n, lane);
        asm volatile("" ::: "memory");
        *(u32x4*)(idxg + ((size_t)b * T + t) * 256 + lane * 4) = *(const LAS u32x4*)(idx + lane * 4);
        asm volatile("" ::: "memory");
    }
}
__device__ __forceinline__ void dsa_attn_phase(const bf16_t* qkv, const int* idxg, bf16_t* att, LAS unsigned char* wl, int bid, int G, int wave, int lane) {
    const int r32 = lane & 31, hi = lane >> 5, g = r32 & 7;
    LAS int* idx = (LAS int*)(wl + 16384);
    int u0, u1, du;
    if ((G & 7) == 0) { const int x = bid & 7; u0 = x * T + (bid >> 3) * 8 + wave; u1 = (x + 1) * T; du = G; }
    else { u0 = bid * 8 + wave; u1 = 8 * T; du = G * 8; }
    for (int u = u0; u < u1; u += du) {
        const int x = u / T, t = u % T, b = x >> 2, kvh = x & 3;
        const size_t rb = (size_t)b * T; const int count = min(256, t + 1), ntiles = (count + 63) >> 6;
        *(LAS u32x4*)(idx + lane * 4) = *(const u32x4*)(idxg + (rb + t) * 256 + lane * 4);
        bf16x8 qr[4];
        const bf16_t* qp = qkv + (rb + t) * LDQ + QOFF + (kvh * 8 + g) * 64 + 8 * hi;
#pragma unroll
        for (int ks = 0; ks < 4; ++ks) qr[ks] = *(const bf16x8*)(qp + 16 * ks);
        asm volatile("" ::: "memory");
        f32x16 o0 = {}, o1 = {}; float m = -__builtin_inff(), l = 0.f;
        attn_run<true, 1>(wl, qkv + rb * LDQ + KOFF + kvh * 64, qkv + rb * LDQ + VOFF + kvh * 64, qr, ntiles, 0, 1, count - 1, 0x7fffffffu, o0, o1, m, l, lane);
        l += __shfl_xor(l, 32);
        if (r32 < 8) attn_store(att + (rb + t) * D + (kvh * 8 + g) * 64, o0, o1, 1.0f / l, hi);
    }
}
__device__ __forceinline__ float xq16(float v, int qp) { const unsigned u = __float_as_uint(v); auto rr = __builtin_amdgcn_permlane16_swap(u, u, false, false); return __uint_as_float((qp & 1) ? rr[0] : rr[1]); }
__device__ __forceinline__ void dsa_tile16(const LAS unsigned char* Kt, const LAS unsigned char* Vt, bf16x8 (&q16)[2], int slot0, int count,
                                           f32x4 (&o)[4], float& m, float& l, int c16, int qp, int hi, int vb16, const bf16_t* qnext) {
    const float NINF = -__builtin_inff();
    f32x4 s[4];
    __builtin_amdgcn_s_setprio(1);
#pragma unroll
    for (int kb = 0; kb < 4; ++kb) {
        s[kb] = (f32x4){0.f, 0.f, 0.f, 0.f};
        const int key = 16 * kb + c16, sw = (key >> 1) & 7;
#pragma unroll
        for (int ks = 0; ks < 2; ++ks) {
            const bf16x8 a = *(const LAS bf16x8*)(Kt + key * 128 + (((4 * ks + qp) ^ sw) * 16));
            s[kb] = __builtin_amdgcn_mfma_f32_16x16x32_bf16(a, q16[ks], s[kb], 0, 0, 0);
        }
    }
    __builtin_amdgcn_s_setprio(0);
    if (qnext) {
#pragma unroll
        for (int ks = 0; ks < 2; ++ks) q16[ks] = *(const bf16x8*)(qnext + 32 * ks);
    }
    float mx = NINF;
#pragma unroll
    for (int kb = 0; kb < 4; ++kb)
#pragma unroll
        for (int i = 0; i < 4; ++i) s[kb][i] *= C2;
    if (slot0 + 64 > count) {
#pragma unroll
        for (int kb = 0; kb < 4; ++kb)
#pragma unroll
            for (int i = 0; i < 4; ++i) s[kb][i] = (slot0 + 16 * kb + 4 * qp + i < count) ? s[kb][i] : NINF;
    }
#pragma unroll
    for (int kb = 0; kb < 4; ++kb) mx = __builtin_fmaxf(__builtin_fmaxf(mx, __builtin_fmaxf(s[kb][0], s[kb][1])), __builtin_fmaxf(s[kb][2], s[kb][3]));
    mx = __builtin_fmaxf(mx, xq16(mx, qp)); mx = __builtin_fmaxf(mx, xhalf(mx, hi));
    if (__any(mx > m + 6.0f)) {
        const float mn = __builtin_fmaxf(m, mx), mu2 = (mn == NINF) ? 0.f : mn, alpha = ex2(m - mu2);
        m = mn; l *= alpha;
#pragma unroll
        for (int db = 0; db < 4; ++db) o[db] *= alpha;
    }
    const float mu = (m == NINF) ? 0.f : m;
    float ls = 0.f;
#pragma unroll
    for (int kb = 0; kb < 4; ++kb)
#pragma unroll
        for (int i = 0; i < 4; ++i) { s[kb][i] = ex2(s[kb][i] - mu); ls += s[kb][i]; }
    l += ls;
    bf16x8 pb[2];
#pragma unroll
    for (int s2 = 0; s2 < 2; ++s2) { u32x4 w;
        w.x = pg8::cvt_pk_bf16(s[2 * s2][0], s[2 * s2][1]); w.y = pg8::cvt_pk_bf16(s[2 * s2][2], s[2 * s2][3]);
        w.z = pg8::cvt_pk_bf16(s[2 * s2 + 1][0], s[2 * s2 + 1][1]); w.w = pg8::cvt_pk_bf16(s[2 * s2 + 1][2], s[2 * s2 + 1][3]);
        pb[s2] = __builtin_bit_cast(bf16x8, w); }
    __builtin_amdgcn_s_setprio(1);
#pragma unroll
    for (int db = 0; db < 4; ++db)
#pragma unroll
        for (int s2 = 0; s2 < 2; ++s2) {
            const LAS unsigned char* vp = Vt + (db >> 1) * 4096 + (db & 1) * 32 + s2 * 2048 + vb16;
            const s16x4 lo = vtr(vp), hi4 = vtr(vp + 1024);
            const bf16x8 vf = (bf16x8){lo[0], lo[1], lo[2], lo[3], hi4[0], hi4[1], hi4[2], hi4[3]};
            o[db] = __builtin_amdgcn_mfma_f32_16x16x32_bf16(vf, pb[s2], o[db], 0, 0, 0);
        }
    __builtin_amdgcn_s_setprio(0);
}
__device__ __forceinline__ void dsa_attn_phase3(const bf16_t* qkv, const int* idxg, bf16_t* att, LAS unsigned char* wl, int bid, int G, int wave, int lane) {
    const int c16 = lane & 15, qp = lane >> 4, hi = lane >> 5, g = c16 & 7;
    LAS unsigned char* Kl = wl; LAS unsigned char* Vl = wl + 8192;
    LAS int* idxb0 = (LAS int*)(wl + 16384); LAS int* idxb1 = (LAS int*)(wl + 17408);
    const int srow_ = lane >> 3, sc_ = lane & 7;
    const int vb16 = (4 * qp + ((lane & 15) >> 2)) * 64 + (lane & 3) * 8;
    int u0, u1, du;
    if ((G & 7) == 0) { const int x = bid & 7; u0 = x * T + (bid >> 3) * 8 + wave; u1 = (x + 1) * T; du = G; }
    else { u0 = bid * 8 + wave; u1 = 8 * T; du = G * 8; }
    if (u0 >= u1) return;
    u32x4 kreg[8], vreg[8];
#define D3_LOAD(idp_, Kg_, t_) do { _Pragma("unroll") for (int i_ = 0; i_ < 8; ++i_) { const int p_ = (idp_)[64 * (t_) + 8 * i_ + srow_]; \
      const bf16_t* rp_ = (Kg_) + (size_t)p_ * LDQ + sc_ * 8; kreg[i_] = *(const u32x4*)rp_; vreg[i_] = *(const u32x4*)(rp_ + (VOFF - KOFF)); } } while (0)
#define D3_STORE() do { _Pragma("unroll") for (int i_ = 0; i_ < 8; ++i_) { const int key_ = 8 * i_ + srow_; \
      *(LAS u32x4*)(Kl + key_ * 128 + ((sc_ ^ ((key_ >> 1) & 7)) * 16)) = kreg[i_]; \
      *(LAS u32x4*)(Vl + (sc_ >> 2) * 4096 + key_ * 64 + (sc_ & 3) * 16) = vreg[i_]; } } while (0)
    int u = u0;
    int t = u % T, kvh = (u / T) & 3; size_t rb = (size_t)((u / T) >> 2) * T;
    const bf16_t* Kg = qkv + rb * LDQ + KOFF + kvh * 64;
    *(LAS u32x4*)(idxb0 + lane * 4) = *(const u32x4*)(idxg + (rb + t) * 256 + lane * 4);
    bf16x8 q16[2];
    { const bf16_t* qp_ = qkv + (rb + t) * LDQ + QOFF + (kvh * 8 + g) * 64 + 8 * qp;
#pragma unroll
      for (int ks = 0; ks < 2; ++ks) q16[ks] = *(const bf16x8*)(qp_ + 32 * ks); }
    asm volatile("" ::: "memory");
    D3_LOAD(idxb0, Kg, 0); asm volatile("" ::: "memory"); D3_STORE(); asm volatile("" ::: "memory");
    int cur = 0;
    for (;;) {
        const int un = u + du; const bool has_next = un < u1;
        const int tn = un % T, kvhn = (un / T) & 3; const size_t rbn = (size_t)((un / T) >> 2) * T;
        const bf16_t* Kgn = qkv + rbn * LDQ + KOFF + kvhn * 64;
        u32x4 idxn = {};
        if (has_next) idxn = *(const u32x4*)(idxg + (rbn + tn) * 256 + lane * 4);
        LAS int* idc = cur ? idxb1 : idxb0; LAS int* idn = cur ? idxb0 : idxb1;
        const int count = min(256, t + 1), ntiles = (count + 63) >> 6;
        f32x4 o[4] = {}; float m = -__builtin_inff(), l = 0.f;
        for (int tl = 0; tl < ntiles; ++tl) {
            if (tl + 1 < ntiles) D3_LOAD(idc, Kg, tl + 1);
            else if (has_next) { *(LAS u32x4*)(idn + lane * 4) = idxn; asm volatile("" ::: "memory"); D3_LOAD(idn, Kgn, 0); }
            const bf16_t* qnp = (tl + 1 == ntiles && has_next) ? qkv + (rbn + tn) * LDQ + QOFF + (kvhn * 8 + g) * 64 + 8 * qp : nullptr;
            dsa_tile16(Kl, Vl, q16, 64 * tl, count, o, m, l, c16, qp, hi, vb16, qnp);
            asm volatile("" ::: "memory");
            if (tl + 1 < ntiles || has_next) D3_STORE();
            asm volatile("" ::: "memory");
        }
        l += xq16(l, qp); l += xhalf(l, hi);
        if (c16 < 8) {
            const float inv = 1.0f / l; bf16_t* op = att + (rb + t) * D + (kvh * 8 + g) * 64 + 4 * qp;
#pragma unroll
            for (int db = 0; db < 4; ++db) { u32x2 w; w.x = pg8::cvt_pk_bf16(o[db][0] * inv, o[db][1] * inv); w.y = pg8::cvt_pk_bf16(o[db][2] * inv, o[db][3] * inv); *(u32x2*)(op + 16 * db) = w; }
        }
        if (!has_next) break;
        u = un; t = tn; kvh = kvhn; rb = rbn; Kg = Kgn; cur ^= 1;
    }
#undef D3_LOAD
#undef D3_STORE
}
__device__ __forceinline__ void dsa_fused_phase(const bf16_t* qkv, const float* scores, bf16_t* att, LAS unsigned char* wl, int gw, int NGW, int lane) {
    const int c16 = lane & 15, qp = lane >> 4, hi = lane >> 5, g = c16 & 7;
    LAS unsigned char* Kl = wl; LAS unsigned char* Vl = wl + 8192; LAS int* idx = (LAS int*)(wl + 16384);
    const int srow_ = lane >> 3, sc_ = lane & 7;
    const int vb16 = (4 * qp + ((lane & 15) >> 2)) * 64 + (lane & 3) * 8;
    for (int u = gw; u < M; u += NGW) {
        const int b = u / T, tt = u % T, t = ((tt >> 11) & 1) ? ((tt & ~2047) + 2047 - (tt & 2047)) : tt;
        const size_t rb = (size_t)b * T; const int n = t + 1, count = min(256, n), ntiles = (count + 63) >> 6;
        const float* srow = scores + score_off(b, t);
        if (n <= 256) { for (int i = lane; i < 256; i += 64) idx[i] = (i < n) ? i : 0; }
        else select256(wl, srow, n, lane);
        asm volatile("" ::: "memory");
        const bf16_t* Kg0 = qkv + rb * LDQ + KOFF;
        bf16x8 q16[2];
        { const bf16_t* qp_ = qkv + (rb + t) * LDQ + QOFF + g * 64 + 8 * qp;
#pragma unroll
          for (int ks = 0; ks < 2; ++ks) q16[ks] = *(const bf16x8*)(qp_ + 32 * ks); }
        u32x4 kreg[8], vreg[8];
#define DF_LOAD(Kg_, t_) do { _Pragma("unroll") for (int i_ = 0; i_ < 8; ++i_) { const int p_ = idx[64 * (t_) + 8 * i_ + srow_]; \
      const bf16_t* rp_ = (Kg_) + (size_t)p_ * LDQ + sc_ * 8; kreg[i_] = *(const u32x4*)rp_; vreg[i_] = *(const u32x4*)(rp_ + (VOFF - KOFF)); } } while (0)
#define DF_STORE() do { asm volatile("" ::: "memory"); _Pragma("unroll") for (int i_ = 0; i_ < 8; ++i_) { const int key_ = 8 * i_ + srow_; \
      *(LAS u32x4*)(Kl + key_ * 128 + ((sc_ ^ ((key_ >> 1) & 7)) * 16)) = kreg[i_]; \
      *(LAS u32x4*)(Vl + (sc_ >> 2) * 4096 + key_ * 64 + (sc_ & 3) * 16) = vreg[i_]; } asm volatile("" ::: "memory"); } while (0)
        DF_LOAD(Kg0, 0); DF_STORE();
        for (int kvh = 0; kvh < 4; ++kvh) {
            const bf16_t* Kg = Kg0 + kvh * 64;
            f32x4 o[4] = {}; float m = -__builtin_inff(), l = 0.f;
            for (int tl = 0; tl < ntiles; ++tl) {
                const bool last = tl + 1 == ntiles, nxt = last && kvh < 3;
                if (!last) DF_LOAD(Kg, tl + 1); else if (nxt) DF_LOAD(Kg + 64, 0);
                dsa_tile16(Kl, Vl, q16, 64 * tl, count, o, m, l, c16, qp, hi, vb16, nxt ? qkv + (rb + t) * LDQ + QOFF + ((kvh + 1) * 8 + g) * 64 + 8 * qp : nullptr);
                if (!last || nxt) DF_STORE();
            }
            l += xq16(l, qp); l += xhalf(l, hi);
            if (c16 < 8) {
                const float inv = 1.0f / l; bf16_t* op = att + (rb + t) * D + (kvh * 8 + g) * 64 + 4 * qp;
#pragma unroll
                for (int db = 0; db < 4; ++db) { u32x2 w; w.x = pg8::cvt_pk_bf16(o[db][0] * inv, o[db][1] * inv); w.y = pg8::cvt_pk_bf16(o[db][2] * inv, o[db][3] * inv); *(u32x2*)(op + 16 * db) = w; }
            }
        }
#undef DF_LOAD
#undef DF_STORE
        asm volatile("" ::: "memory");
    }
}
__device__ __forceinline__ void final_phase(float* out, const bf16_t* xbf, const unsigned long long* ss, const float* gfin, int gw, int NGW, int lane) {
    for (int row = gw; row < M; row += NGW) {
        const float rs = 1.0f / sqrtf((float)ss[row] * (SS_INV / D) + RMS_EPS);
        const u32x4* xr = (const u32x4*)(xbf + (size_t)row * D) + lane; f32x4* orow = (f32x4*)(out + (size_t)row * D); const f32x4* gr = (const f32x4*)gfin;
#pragma unroll
        for (int jj = 0; jj < 4; ++jj) {
            const u32x4 w = xr[64 * jj]; const int c4 = 128 * jj + 2 * lane;
            const f32x4 g0 = gr[c4], g1 = gr[c4 + 1];
            f32x4 v0, v1;
            v0.x = __uint_as_float(w.x << 16); v0.y = __uint_as_float(w.x & 0xffff0000u); v0.z = __uint_as_float(w.y << 16); v0.w = __uint_as_float(w.y & 0xffff0000u);
            v1.x = __uint_as_float(w.z << 16); v1.y = __uint_as_float(w.z & 0xffff0000u); v1.z = __uint_as_float(w.w << 16); v1.w = __uint_as_float(w.w & 0xffff0000u);
            orow[c4] = v0 * rs * g0; orow[c4 + 1] = v1 * rs * g1;
        }
    }
}
#define XB_TMO      128
#define XB_XCNT(j)  (256  + 64 * (j))
#define XB_XSUB(j)  (1280 + 64 * (j))
#define XB_XGEN(j)  (2304 + 64 * (j))
#define XB_TOP      3328
#define XB_TOPGEN   3392
#define XCD_BAR_WORDS 3456
#define XB_SPIN_CAP (1u << 18)

__device__ __forceinline__ unsigned xb_ld(unsigned* p)              { return __hip_atomic_load(p, __ATOMIC_RELAXED, __HIP_MEMORY_SCOPE_AGENT); }
__device__ __forceinline__ unsigned xb_add(unsigned* p, unsigned v) { return __hip_atomic_fetch_add(p, v, __ATOMIC_RELAXED, __HIP_MEMORY_SCOPE_AGENT); }
__device__ __forceinline__ unsigned xb_xcc_id() { return (unsigned)__builtin_amdgcn_s_getreg((3 << 11) | 20) & 0xFu; }
#define XB_SPIN(cond, bar) do { unsigned _sp = 0; while (cond) { __builtin_amdgcn_s_sleep(1); \
    if ((++_sp & 255u) == 0u) { if (xb_ld(&(bar)[XB_TMO])) break; if (_sp > XB_SPIN_CAP) { atomicAdd(&(bar)[XB_TMO], 1u); break; } } } } while (0)

struct XcdBarrier {
    unsigned* bar; unsigned x;
    volatile LAS unsigned* st;
};

__device__ __forceinline__ XcdBarrier xcd_barrier_post(unsigned* bar, volatile LAS unsigned* st) {
    XcdBarrier b; b.bar = bar; b.x = xb_xcc_id(); b.st = st;
    if (threadIdx.x == 0) (void)xb_add(&bar[XB_XCNT(b.x)], 1u);
    return b;
}
__device__ __forceinline__ void xcd_barrier_complete(unsigned* bar, unsigned x, unsigned& nloc, unsigned& nx) {
    const unsigned G = gridDim.x * gridDim.y * gridDim.z;
    unsigned sum, cnt, mine, sp = 0u;
    for (;;) {
        sum = 0u; cnt = 0u; mine = 0u;
#pragma unroll
        for (unsigned j = 0; j < 16; ++j) { const unsigned c = xb_ld(&bar[XB_XCNT(j)]); sum += c; cnt += (c > 0u) ? 1u : 0u; mine = (j == x) ? c : mine; }
        if (sum == G) break;
        __builtin_amdgcn_s_sleep(1);
        if ((++sp & 255u) == 0u) { if (xb_ld(&bar[XB_TMO])) break; if (sp > XB_SPIN_CAP) { atomicAdd(&bar[XB_TMO], 1u); break; } }
    }
    nloc = mine > 0u ? mine : 1u; nx = cnt > 0u ? cnt : 1u;
}

__device__ __forceinline__ void xcd_barrier(const XcdBarrier& b) {
    asm volatile("s_waitcnt vmcnt(0)" ::: "memory");
    __syncthreads();
    if (threadIdx.x == 0) {
        unsigned* bar = b.bar;
        __builtin_amdgcn_s_waitcnt(0);
        unsigned nloc = b.st[0], nx = b.st[1];
        if (nloc == 0u) { xcd_barrier_complete(bar, b.x, nloc, nx); b.st[0] = nloc; b.st[1] = nx; }
        const unsigned old = xb_add(&bar[XB_XSUB(b.x)], 1u);
        const unsigned gen = old / nloc;
        if (old + 1u == (gen + 1u) * nloc) {
            __builtin_amdgcn_fence(__ATOMIC_RELEASE, "agent");
            asm volatile("s_waitcnt vmcnt(0)" ::: "memory");
            const unsigned og = xb_add(&bar[XB_TOP], 1u);
            const unsigned tg = og / nx;
            if (og + 1u == (tg + 1u) * nx) xb_add(&bar[XB_TOPGEN], 1u);
            else XB_SPIN(xb_ld(&bar[XB_TOPGEN]) == tg, bar);
            __builtin_amdgcn_fence(__ATOMIC_ACQUIRE, "agent");
            xb_add(&bar[XB_XGEN(b.x)], 1u);
            asm volatile("s_waitcnt vmcnt(0)" ::: "memory");
        } else {
            XB_SPIN(xb_ld(&bar[XB_XGEN(b.x)]) == gen, bar);
            __builtin_amdgcn_fence(__ATOMIC_ACQUIRE, "agent");
            asm volatile("s_waitcnt vmcnt(0)" ::: "memory");
        }
    }
    __syncthreads();
}

#ifndef REP_PRO
#define REP_PRO 1
#endif
#ifndef REP_IDX
#define REP_IDX 1
#endif
#ifndef REP_SWA
#define REP_SWA 1
#endif
#ifndef REP_DSA
#define REP_DSA 1
#endif
#ifndef REP_SEL
#define REP_SEL 1
#endif
#ifndef REP_GQKV
#define REP_GQKV 1
#endif
#ifndef REP_GUP
#define REP_GUP 1
#endif
#ifndef REP_DIL
#define REP_DIL 1
#endif
#ifndef PG8_SP2
#define PG8_SP2 true
#endif
#ifndef PG8_ALIGN
#define PG8_ALIGN true
#endif

__global__ void __launch_bounds__(512, 2) mega(Args a) {
    extern __shared__ __attribute__((aligned(16))) unsigned char lds_raw[];
    cg::grid_group grid = cg::this_grid();
    LAS unsigned char* lds = (LAS unsigned char*)lds_raw;
    const int tid = threadIdx.x, lane = tid & 63, wave = __builtin_amdgcn_readfirstlane(tid >> 6);
    const int G = gridDim.x, gw = blockIdx.x * 8 + wave, NGW = G * 8;
    LAS unsigned char* wl = lds + wave * WAVE_LDS;
    unsigned char* ws = a.ws;
    unsigned long long* ss = (unsigned long long*)(ws + WS_SS); const float* rope = (const float*)(ws + WS_ROPE); float* wi32 = (float*)(ws + WS_WI);
    bf16_t* xb = (bf16_t*)(ws + WS_XB); bf16_t* qkv = (bf16_t*)(ws + WS_QKV); bf16_t* att = (bf16_t*)(ws + WS_ATT); bf16_t* hid = (bf16_t*)(ws + WS_H); float* scores = (float*)(ws + WS_H); int* idxg = (int*)(ws + WS_XB);
    const int lo = a.ph_lo, hi = a.ph_hi;
    int ph = 0;
    volatile LAS unsigned* bst = (volatile LAS unsigned*)(lds + LDS_BYTES - 64);
    if (tid < 16) ((LAS unsigned*)(lds + LDS_BYTES - 64))[tid] = 0u;
    __syncthreads();
    XcdBarrier bar; bar.bar = (unsigned*)(ws + WS_BAR); bar.x = 0; bar.st = bst;
    if (hi - lo > 1) bar = xcd_barrier_post((unsigned*)(ws + WS_BAR), bst);
    bool first_sync = true;
#define PH_BEGIN if (ph >= lo && ph < hi) { int ln = threadIdx.x & 63; asm volatile("" : "+v"(ln));
#define PH_END   if (ph + 1 < hi) { if (first_sync) { grid.sync(); first_sync = false; } else xcd_barrier(bar); } } ++ph;

    PH_BEGIN
#ifndef SKIP_PRO
 for (int rep_ = 0; rep_ < REP_PRO; ++rep_) prologue(a, lds, gw, NGW, wave, ln);
#endif
 PH_END

    for (int L = 0; L < NLAYER; ++L) {
        const int kind = L % 3, jl = L / 3;
        const int NQ = (kind == 1) ? 3840 : 2560;
        const float* xin = (L == 0) ? a.in[0] : a.out;
        PH_BEGIN {
            pg8::Gemm g{xb, (const bf16_t*)(ws + win_off(L)), M, NQ, D}; pg8::StaticOrder S; S.init(M, NQ, G, (int)blockIdx.x);
            pg8::EpiQKV E{qkv, ss + (size_t)(2 * L) * M, rope, wi32};
#ifndef SKIP_GQKV
            for (int rep_ = 0; rep_ < REP_GQKV; ++rep_) pg8::gemm_phase<pg8::EpiQKV, pg8::StaticOrder, PG8_ALIGN, PG8_SP2>(lds, g, S, E);
#endif
            {
                const int nwg = (M / 256) * (NQ / 256), maxu = (nwg + G - 1) / G, rfull = nwg - (maxu - 1) * G;
                const bool all = rfull >= G; const int bidx = (int)blockIdx.x;
                if (all || bidx >= rfull) {
                    const int niw = (all ? G : G - rfull) * 8, iw = (all ? bidx : bidx - rfull) * 8 + wave;
                    for (int it = iw; it < (FF / 64) * (D / 64); it += niw) tr_item(a.in[5] + (size_t)L * FF * D, nullptr, FF, D, D, (bf16_t*)(ws + WS_WDN + (size_t)L * 32 * MiB), it, ln);
                    if (kind != 1) for (int it = iw; it < (D / 64) * (FF / 64); it += niw) tr_item(a.in[4] + (size_t)L * D * FF, a.in[3] + L * D, D, FF, FF, (bf16_t*)(ws + WS_WUP + (size_t)L * 32 * MiB), it, ln);
                }
            }
        } PH_END
        if (kind == 1) { PH_BEGIN
#ifndef SKIP_IDX
 for (int rep_ = 0; rep_ < REP_IDX; ++rep_) indexer_phase_wg(qkv, wi32, scores, lds, (int)blockIdx.x, G, (wave << 6) | ln, wave, ln);
#endif
 PH_END }
        PH_BEGIN {
#ifndef SKIP_SWA
            if (kind == 0) for (int rep_ = 0; rep_ < REP_SWA; ++rep_) swa_phase_wg(qkv, a.in[8] + jl * 32, att, lds, (int)blockIdx.x, G, (wave << 6) | ln, wave, ln);
#endif
#ifndef SKIP_DSA
            if (kind == 1) for (int rep_ = 0; rep_ < REP_DSA; ++rep_) dsa_fused_phase(qkv, scores, att, wl, gw, NGW, ln);
#endif
#ifndef SKIP_DIL
            if (kind == 2) for (int rep_ = 0; rep_ < REP_DIL; ++rep_) dil_phase(qkv, att, wl, gw, NGW, ln);
#endif
        } PH_END
        for (int st = 0; st < 3; ++st) {
            PH_BEGIN {
                if (st == 1) {
                    pg8::Gemm g{xb, (const bf16_t*)(ws + WS_WUP + (size_t)L * 32 * MiB), M, FF, D}; pg8::StaticOrder S; S.init(M, FF, G, (int)blockIdx.x);
                    pg8::EpiUp E{hid, ss + (size_t)(2 * L + 1) * M, FF};
#ifndef SKIP_GUP
                    for (int rep_ = 0; rep_ < REP_GUP; ++rep_) pg8::gemm_phase<pg8::EpiUp, pg8::StaticOrder, PG8_ALIGN, PG8_SP2>(lds, g, S, E);
#endif
                } else {
                    const bf16_t* Am = (st == 0) ? att : hid; const int Kd = (st == 0) ? D : FF;
                    const bf16_t* Bm = (st == 0) ? (const bf16_t*)(ws + WS_WOUT + (size_t)L * 8 * MiB) : (const bf16_t*)(ws + WS_WDN + (size_t)L * 32 * MiB);
                    pg8::Gemm g{Am, Bm, M, D, Kd}; pg8::StaticOrder S; S.init(M, D, G, (int)blockIdx.x);
                    const bool lastres = (st == 2 && L == NLAYER - 1);
                    pg8::EpiRes E{(st == 0) ? xin : a.out, lastres ? nullptr : a.out, xb, ss + (size_t)(2 * L + 1 + (st == 2 ? 1 : 0)) * M};
#ifndef SKIP_GRES
                    pg8::gemm_phase<pg8::EpiRes, pg8::StaticOrder, PG8_ALIGN, PG8_SP2>(lds, g, S, E);
#endif
                }
            } PH_END
        }
    }
#ifdef EXTRA_SYNCS
    if (hi - lo > 1) for (int i_ = 0; i_ < EXTRA_SYNCS; ++i_) xcd_barrier(bar);
#endif
    PH_BEGIN
#ifndef SKIP_FIN
 final_phase(a.out, xb, ss + (size_t)8 * M, a.in[6], gw, NGW, ln);
#endif
 PH_END
#undef PH_BEGIN
#undef PH_END
}
}

#ifndef MK_MULTI
#define MK_MULTI 0
#endif
extern "C" void kernel_launch(void* const* d_in, const int* in_sizes, int n_in, void* d_out, int out_size, void* d_ws, size_t ws_size, hipStream_t stream) {
    static int grid = 0;
    if (grid == 0) {
        if (n_in != 14 || ws_size < mk::WS_END) { fprintf(stderr, "kernel_launch: unexpected inputs (n_in %d, ws %zu)\n", n_in, ws_size); grid = -1; return; }
        int dev = 0, cus = 0, per_cu = 0;
        hipGetDevice(&dev); hipDeviceGetAttribute(&cus, hipDeviceAttributeMultiprocessorCount, dev);
        if (hipFuncSetAttribute((const void*)mk::mega, hipFuncAttributeMaxDynamicSharedMemorySize, mk::LDS_BYTES) != hipSuccess) { fprintf(stderr, "kernel_launch: hipFuncSetAttribute failed\n"); grid = -1; return; }
        if (hipOccupancyMaxActiveBlocksPerMultiprocessor(&per_cu, (const void*)mk::mega, 512, mk::LDS_BYTES) != hipSuccess || per_cu < 1) { fprintf(stderr, "kernel_launch: occupancy query gave %d\n", per_cu); per_cu = 1; }
        (void)hipGetLastError();
        grid = cus * per_cu;
        fprintf(stderr, "kernel_launch: grid %d (cus %d x %d)\n", grid, cus, per_cu);
    }
    if (grid < 0) return;
    mk::Args a{};
    for (int i = 0; i < 14; ++i) a.in[i] = (const float*)d_in[i];
    a.out = (float*)d_out; a.ws = (unsigned char*)d_ws;
    if (hipMemsetAsync((char*)d_ws + mk::WS_BAR, 0, 16384, stream) != hipSuccess) { fprintf(stderr, "kernel_launch: memset failed\n"); return; }
#if MK_MULTI
    for (int p = 0; p < mk::NPHASE; ++p) { a.ph_lo = p; a.ph_hi = p + 1; hipLaunchKernelGGL(mk::mega, dim3(grid), dim3(512), mk::LDS_BYTES, stream, a); }
#else
    a.ph_lo = 0; a.ph_hi = mk::NPHASE;
    void* args[] = {&a};
    hipError_t e = hipLaunchCooperativeKernel((const void*)mk::mega, dim3(grid), dim3(512), args, mk::LDS_BYTES, stream);
    if (e != hipSuccess) fprintf(stderr, "cooperative launch failed: %s (grid %d)\n", hipGetErrorString(e), grid);
#endif
}
```
